# Optimizing an MI355X kernel written in HIP

```python
import jax, jax.numpy as jnp
from jax import lax
import numpy as np

D_MODEL = 1024
BATCH = 8
SEQ = 4096
DEPTH = 2

CHUNK = 64
BLOCK = 128
N_META = 16
PAD_FRONT = BLOCK - N_META
HEAD_DIM = 64
NORM_EPS = 1e-6
NEG = -1e30
SWA_HEADS = 4
SWA_KV_HEADS = 2
WINDOW = 128
WIN_CHUNKS = WINDOW // CHUNK
FOX_HEADS = 4
MLA_HEADS = 4
MLA_Q_LORA = 256
MLA_KV_LORA = 128
MLA_NOPE = 64
MLA_ROPE = 32
MLA_V = 64
ROPE_THETA = 10000.0
SB_HEADS = 4
IN_SIZES = (SWA_HEADS * HEAD_DIM, SWA_KV_HEADS * HEAD_DIM, SWA_KV_HEADS * HEAD_DIM,
            FOX_HEADS * HEAD_DIM, FOX_HEADS * HEAD_DIM, FOX_HEADS * HEAD_DIM, FOX_HEADS,
            MLA_Q_LORA, MLA_KV_LORA, MLA_ROPE,
            SB_HEADS * HEAD_DIM, SB_HEADS * HEAD_DIM, SB_HEADS * HEAD_DIM)
IN_COLS = sum(IN_SIZES)
SPLIT_POINTS = tuple(int(c) for c in np.cumsum(IN_SIZES)[:-1])
MIX_WIDTH = SWA_HEADS * HEAD_DIM + FOX_HEADS * HEAD_DIM + MLA_HEADS * MLA_V + SB_HEADS * HEAD_DIM
N_GROUPS = 4
EXPERTS_PER_GROUP = 8
N_EXPERTS = N_GROUPS * EXPERTS_PER_GROUP
TOP_K = 2
EXPERT_HIDDEN = 512
MOE_BLOCK = 256

kernel_name = "hymba_style_parallel_hybrid_hmoe"


def rms_norm(x, g):
    xf = x.astype(jnp.float32)
    y = xf * lax.rsqrt(jnp.mean(xf * xf, axis=-1, keepdims=True) + NORM_EPS)
    return (y * g.astype(jnp.float32)).astype(x.dtype)


def seq_layout(L):
    p = jnp.arange(L, dtype=jnp.int32)
    pos = p - PAD_FRONT
    cid = jnp.where(p < PAD_FRONT, -1, jnp.where(p < BLOCK, 0, (p - BLOCK) // CHUNK + 1))
    return pos, cid.astype(jnp.int32)


def key_ok(ct, cs):
    return (cs >= 0) | (ct < 0)


def alibi_slopes(n):
    return jnp.asarray([2.0 ** (-8.0 * (h + 1) / n) for h in range(n)], jnp.float32)


def rope(x, pos):
    half = x.shape[-1] // 2
    inv_freq = ROPE_THETA ** (-jnp.arange(half, dtype=jnp.float32) / half)
    ang = pos.astype(jnp.float32)[:, None] * inv_freq[None, :]
    cos = jnp.cos(ang)[None, :, None, :]
    sin = jnp.sin(ang)[None, :, None, :]
    xf = x.astype(jnp.float32)
    x1, x2 = xf[..., :half], xf[..., half:]
    return jnp.concatenate([x1 * cos - x2 * sin, x1 * sin + x2 * cos], axis=-1).astype(x.dtype)


def to_blocks(x):
    B, L = x.shape[:2]
    return jnp.moveaxis(x.reshape(B, L // BLOCK, BLOCK, *x.shape[2:]), 1, 0)


def from_blocks(y):
    y = jnp.moveaxis(y, 0, 1)
    return y.reshape(y.shape[0], -1, *y.shape[3:])


def with_prev_block(x, axis, fill):
    first = jnp.full_like(lax.slice_in_dim(x, 0, 1, axis=axis), fill)
    prev = jnp.concatenate([first, lax.slice_in_dim(x, 0, x.shape[axis] - 1, axis=axis)], axis=axis)
    return jnp.concatenate([prev, x], axis=axis + 1)


def swa_sink_attention(q, k, v, sinks, pos, cid):
    B, L = q.shape[:2]
    nb = L // BLOCK
    grp = SWA_HEADS // SWA_KV_HEADS
    qb = q.reshape(B, nb, BLOCK, SWA_KV_HEADS, grp, HEAD_DIM)
    k_band = with_prev_block(k.reshape(B, nb, BLOCK, SWA_KV_HEADS, HEAD_DIM), 1, 0)
    v_band = with_prev_block(v.reshape(B, nb, BLOCK, SWA_KV_HEADS, HEAD_DIM), 1, 0)
    k_meta = k[:, PAD_FRONT:BLOCK]
    v_meta = v[:, PAD_FRONT:BLOCK]
    pos_q = pos.reshape(nb, BLOCK)
    cid_q = cid.reshape(nb, BLOCK)
    pos_band = with_prev_block(pos_q, 0, 0)
    cid_band = with_prev_block(cid_q, 0, -2)
    scale = HEAD_DIM ** -0.5
    s_meta = jnp.einsum('bnqhgd,bmhd->bnhgqm', qb, k_meta, preferred_element_type=jnp.float32) * scale
    s_band = jnp.einsum('bnqhgd,bnkhd->bnhgqk', qb, k_band, preferred_element_type=jnp.float32) * scale
    slopes = alibi_slopes(SWA_HEADS).reshape(SWA_KV_HEADS, grp)[:, :, None, None]
    ct = cid_q[:, :, None]
    cs = cid_band[:, None, :]
    band_vis = (cs >= 1) & (cs <= ct) & (cs >= ct - WIN_CHUNKS)
    meta_vis = jnp.broadcast_to(ct >= 0, (nb, BLOCK, N_META))
    d_band = jnp.abs(pos_q[:, :, None] - pos_band[:, None, :]).astype(jnp.float32)
    d_meta = jnp.minimum(jnp.abs(pos_q[:, :, None] - pos[PAD_FRONT:BLOCK][None, None, :]), WINDOW).astype(jnp.float32)
    logits = jnp.concatenate([
        jnp.where(meta_vis[:, None, None], s_meta - slopes * d_meta[:, None, None], NEG),
        jnp.where(band_vis[:, None, None], s_band - slopes * d_band[:, None, None], NEG)], axis=-1)
    sink = sinks.astype(jnp.float32).reshape(SWA_KV_HEADS, grp)[:, :, None, None]
    m = jnp.maximum(jnp.max(logits, axis=-1, keepdims=True), sink)
    e = jnp.exp(logits - m)
    p = (e / (jnp.sum(e, axis=-1, keepdims=True) + jnp.exp(sink - m))).astype(v.dtype)
    out = (jnp.einsum('bnhgqm,bmhd->bnqhgd', p[..., :N_META], v_meta)
           + jnp.einsum('bnhgqk,bnkhd->bnqhgd', p[..., N_META:], v_band))
    return out.reshape(B, L, SWA_HEADS, HEAD_DIM)


def forgetting_attention(q, k, v, log_f, pos, cid):
    F = jnp.cumsum(log_f, axis=1)
    F_keys = jnp.transpose(F, (0, 2, 1))[:, :, None, :]
    scale = HEAD_DIM ** -0.5

    def block(args):
        qb, Fb, pb, cb = args
        s = jnp.einsum('bqhd,bkhd->bhqk', qb, k, preferred_element_type=jnp.float32) * scale
        s = s + (jnp.transpose(Fb, (0, 2, 1))[..., None] - F_keys)
        vis = (pos[None, :] <= pb[:, None]) & key_ok(cb[:, None], cid[None, :])
        p = jax.nn.softmax(jnp.where(vis, s, NEG), axis=-1)
        return jnp.einsum('bhqk,bkhd->bqhd', p.astype(v.dtype), v)

    out = lax.map(block, (to_blocks(q), to_blocks(F), pos.reshape(-1, BLOCK), cid.reshape(-1, BLOCK)))
    return from_blocks(out)


def chunk_causal_attention(q, k, v, cid, scale):
    def block(args):
        qb, cb = args
        s = jnp.einsum('bqhd,bkhd->bhqk', qb, k, preferred_element_type=jnp.float32) * scale
        vis = (cid[None, :] <= cb[:, None]) & key_ok(cb[:, None], cid[None, :])
        p = jax.nn.softmax(jnp.where(vis, s, NEG), axis=-1)
        return jnp.einsum('bhqk,bkhd->bqhd', p.astype(v.dtype), v)

    out = lax.map(block, (to_blocks(q), cid.reshape(-1, BLOCK)))
    return from_blocks(out)


def stick_breaking_attention(q, k, v, pos, cid):
    scale = HEAD_DIM ** -0.5

    def block(args):
        qb, pb, cb = args
        z = jnp.einsum('bqhd,bkhd->bhqk', qb, k, preferred_element_type=jnp.float32) * scale
        vis = (pos[None, :] < pb[:, None]) & key_ok(cb[:, None], cid[None, :])
        log_keep = jnp.where(vis, jax.nn.log_sigmoid(-z), 0.0)
        log_after = lax.cumsum(log_keep, axis=3, reverse=True) - log_keep
        a = jnp.where(vis, jnp.exp(jax.nn.log_sigmoid(z) + log_after), 0.0)
        return jnp.einsum('bhqk,bkhd->bqhd', a.astype(v.dtype), v)

    out = lax.map(block, (to_blocks(q), pos.reshape(-1, BLOCK), cid.reshape(-1, BLOCK)))
    return from_blocks(out)


def token_mixers(u, pos, cid, w_in, b_forget, sinks, q_norm, kv_norm, w_uq, w_ukv, w_out):
    B, L, _ = u.shape
    proj = u @ w_in
    (a_q, a_k, a_v, f_q, f_k, f_v, f_g, c_q, c_kv, c_kr, s_q, s_k, s_v) = jnp.split(proj, SPLIT_POINTS, axis=-1)

    def heads(t, n):
        return t.reshape(B, L, n, -1)

    y_a = swa_sink_attention(heads(a_q, SWA_HEADS), heads(a_k, SWA_KV_HEADS), heads(a_v, SWA_KV_HEADS), sinks, pos, cid)
    log_f = jax.nn.log_sigmoid(f_g.astype(jnp.float32) + b_forget.astype(jnp.float32))
    y_b = forgetting_attention(heads(f_q, FOX_HEADS), heads(f_k, FOX_HEADS), heads(f_v, FOX_HEADS), log_f, pos, cid)
    q_c = (rms_norm(c_q, q_norm) @ w_uq).reshape(B, L, MLA_HEADS, MLA_NOPE + MLA_ROPE)
    kv_c = (rms_norm(c_kv, kv_norm) @ w_ukv).reshape(B, L, MLA_HEADS, MLA_NOPE + MLA_V)
    k_rope = rope(c_kr[:, :, None, :], pos)
    q_mla = jnp.concatenate([q_c[..., :MLA_NOPE], rope(q_c[..., MLA_NOPE:], pos)], axis=-1)
    k_mla = jnp.concatenate([kv_c[..., :MLA_NOPE], jnp.broadcast_to(k_rope, (B, L, MLA_HEADS, MLA_ROPE))], axis=-1)
    y_c = chunk_causal_attention(q_mla, k_mla, kv_c[..., MLA_NOPE:], cid, (MLA_NOPE + MLA_ROPE) ** -0.5)
    y_d = stick_breaking_attention(heads(s_q, SB_HEADS), heads(s_k, SB_HEADS), heads(s_v, SB_HEADS), pos, cid)
    y = jnp.concatenate([y_a.reshape(B, L, -1), y_b.reshape(B, L, -1),
                         y_c.reshape(B, L, -1), y_d.reshape(B, L, -1)], axis=-1)
    return y @ w_out


def hier_moe(x, w_group, b_group, w_router, b_router, w_gate, w_up, w_down):
    B, L, D = x.shape
    T = B * L
    xt = x.reshape(T, D)
    g_logits = (xt @ w_group).astype(jnp.float32) + b_group.astype(jnp.float32)
    g_prob = jax.nn.softmax(g_logits, axis=-1)
    g_top = jnp.argmax(g_logits, axis=-1).astype(jnp.int32)
    g_w = jnp.take_along_axis(g_prob, g_top[:, None], axis=-1)
    e_logits = ((xt @ w_router).astype(jnp.float32) + b_router.astype(jnp.float32)).reshape(T, N_GROUPS, EXPERTS_PER_GROUP)
    e_in_group = jnp.take_along_axis(e_logits, g_top[:, None, None], axis=1)[:, 0]
    top_v, top_i = lax.top_k(e_in_group, TOP_K)
    e_w = jax.nn.softmax(top_v, axis=-1) * g_w
    expert = g_top[:, None] * EXPERTS_PER_GROUP + top_i.astype(jnp.int32)

    A = T * TOP_K
    flat_e = expert.reshape(A)
    flat_tok = jnp.repeat(jnp.arange(T, dtype=jnp.int32), TOP_K)
    flat_w = e_w.reshape(A)
    order = jnp.argsort(flat_e)
    se, stok, sw = flat_e[order], flat_tok[order], flat_w[order]
    counts = jnp.bincount(flat_e, length=N_EXPERTS)
    padded = (counts + MOE_BLOCK - 1) // MOE_BLOCK * MOE_BLOCK
    pad_end = jnp.cumsum(padded)
    pad_start = pad_end - padded
    raw_start = jnp.cumsum(counts) - counts
    dest = pad_start[se] + (jnp.arange(A, dtype=jnp.int32) - raw_start[se])
    P = A + N_EXPERTS * MOE_BLOCK
    n_blk = P // MOE_BLOCK
    rows_tok = jnp.zeros((P,), jnp.int32).at[dest].set(stok)
    rows_w = jnp.zeros((P,), jnp.float32).at[dest].set(sw)
    block_e = jnp.minimum(jnp.searchsorted(pad_end, jnp.arange(n_blk) * MOE_BLOCK, side='right'), N_EXPERTS - 1)
    x_rows = xt[rows_tok].reshape(n_blk, MOE_BLOCK, D)

    def expert_block(args):
        xb, e = args
        hb = jax.nn.silu(xb @ w_gate[e]) * (xb @ w_up[e])
        return hb @ w_down[e]

    y_rows = lax.map(expert_block, (x_rows, block_e)).reshape(P, D)
    y = jnp.zeros((T, D), jnp.float32).at[rows_tok].add(y_rows.astype(jnp.float32) * rows_w[:, None])
    return y.astype(x.dtype).reshape(B, L, D)


def setup_inputs(seed: int = 0) -> dict:
    key = jax.random.key(seed)
    ks = jax.random.split(key, 20)
    f32 = jnp.float32

    def nrm(k, shape, scale):
        return jax.random.normal(k, shape, f32) * scale

    return {
        "x": nrm(ks[0], (BATCH, SEQ, D_MODEL), 1.0),
        "meta_tokens": nrm(ks[1], (N_META, D_MODEL), 1.0),
        "attn_norm": 1.0 + nrm(ks[2], (DEPTH, D_MODEL), 0.02),
        "w_in": nrm(ks[3], (DEPTH, D_MODEL, IN_COLS), D_MODEL ** -0.5),
        "b_forget": jax.random.uniform(ks[4], (DEPTH, FOX_HEADS), f32, 1.0, 4.0),
        "sinks": nrm(ks[5], (DEPTH, SWA_HEADS), 0.5),
        "mla_q_norm": 1.0 + nrm(ks[6], (DEPTH, MLA_Q_LORA), 0.02),
        "mla_kv_norm": 1.0 + nrm(ks[7], (DEPTH, MLA_KV_LORA), 0.02),
        "mla_w_uq": nrm(ks[8], (DEPTH, MLA_Q_LORA, MLA_HEADS * (MLA_NOPE + MLA_ROPE)), MLA_Q_LORA ** -0.5),
        "mla_w_ukv": nrm(ks[9], (DEPTH, MLA_KV_LORA, MLA_HEADS * (MLA_NOPE + MLA_V)), MLA_KV_LORA ** -0.5),
        "w_out": nrm(ks[10], (DEPTH, MIX_WIDTH, D_MODEL), MIX_WIDTH ** -0.5),
        "ffn_norm": 1.0 + nrm(ks[11], (DEPTH, D_MODEL), 0.02),
        "w_group": nrm(ks[12], (DEPTH, D_MODEL, N_GROUPS), D_MODEL ** -0.5),
        "b_group": nrm(ks[13], (DEPTH, N_GROUPS), 0.01),
        "w_router": nrm(ks[14], (DEPTH, D_MODEL, N_EXPERTS), D_MODEL ** -0.5),
        "b_router": nrm(ks[15], (DEPTH, N_EXPERTS), 0.01),
        "w_gate": nrm(ks[16], (DEPTH, N_EXPERTS, D_MODEL, EXPERT_HIDDEN), D_MODEL ** -0.5),
        "w_up": nrm(ks[17], (DEPTH, N_EXPERTS, D_MODEL, EXPERT_HIDDEN), D_MODEL ** -0.5),
        "w_down": nrm(ks[18], (DEPTH, N_EXPERTS, EXPERT_HIDDEN, D_MODEL), EXPERT_HIDDEN ** -0.5),
        "final_norm": 1.0 + nrm(ks[19], (D_MODEL,), 0.02),
    }


def reference(x, meta_tokens, attn_norm, w_in, b_forget, sinks, mla_q_norm, mla_kv_norm,
              mla_w_uq, mla_w_ukv, w_out, ffn_norm, w_group, b_group, w_router, b_router,
              w_gate, w_up, w_down, final_norm):
    B, S, D = x.shape
    L = S + BLOCK
    pad = jnp.zeros((B, PAD_FRONT, D), x.dtype)
    meta = jnp.broadcast_to(meta_tokens.astype(x.dtype)[None], (B, N_META, D))
    h = jnp.concatenate([pad, meta, x], axis=1)
    pos, cid = seq_layout(L)
    for i in range(DEPTH):
        h = h + token_mixers(rms_norm(h, attn_norm[i]), pos, cid, w_in[i], b_forget[i], sinks[i],
                             mla_q_norm[i], mla_kv_norm[i], mla_w_uq[i], mla_w_ukv[i], w_out[i])
        h = h + hier_moe(rms_norm(h, ffn_norm[i]), w_group[i], b_group[i], w_router[i], b_router[i],
                         w_gate[i], w_up[i], w_down[i])
    return rms_norm(h[:, BLOCK:], final_norm)
```

```cpp
#include <hip/hip_runtime.h>
#include <hip/hip_cooperative_groups.h>
#include <cstdio>
#include <cstdint>
namespace cg = cooperative_groups;

#ifndef MK_N_LAUNCHES
#define MK_N_LAUNCHES 1
#endif

constexpr int NB = 8, SEQ = 4096, DM = 1024, LSEQ = SEQ + 128, MROWS = NB * LSEQ;
constexpr int PADF = 112;
constexpr int NPROJ = 2560;
constexpr int C_AQ = 0, C_AK = 256, C_AV = 384, C_FQ = 512, C_FK = 768, C_FV = 1024, C_CQ = 1280, C_CKV = 1536, C_CKR = 1664, C_SQ = 1696, C_SK = 1952, C_SV = 2208, C_FG = 2464;
constexpr int NEXP = 32, EHID = 512;
constexpr float EPS = 1e-6f;
constexpr float LOG2E = 1.4426950408889634f;
constexpr int NWAVES = 8, NTHREADS = 512;
constexpr int HB_META = NB * SEQ, HB_ZERO = NB * SEQ + NB * 16, HB_ROWS = HB_ZERO + 1;
constexpr int PMAX_ROWS = 74240;

constexpr size_t MiB = 1u << 20;
constexpr size_t WS_CTL = 0, CTL_BYTES = 1 * MiB;
constexpr size_t W_IN = 0, W_OUT = W_IN + (size_t)NPROJ * DM * 2, W_UQ = W_OUT + (size_t)DM * DM * 2, W_UKV = W_UQ + 384 * 256 * 2, W_RT = W_UKV + 512 * 128 * 2, W_LAYER = W_RT + 64 * 1024 * 2;
constexpr size_t WM_GU = 0, WM_DN = WM_GU + (size_t)NEXP * 1024 * 1024 * 2, WM_END = WM_DN + (size_t)NEXP * 1024 * 512 * 2;
constexpr size_t WS_W = 1 * MiB;
constexpr size_t WS_WMOE = 17 * MiB;
constexpr size_t WS_HB = 114 * MiB;
constexpr size_t WS_XN = 179 * MiB;
constexpr size_t WS_BIG = 246 * MiB;
constexpr size_t BIG_PROJ = 0, BIG_QM = (size_t)MROWS * NPROJ * 2, BIG_KM = BIG_QM + (size_t)MROWS * 384 * 2, BIG_VM = BIG_KM + (size_t)MROWS * 384 * 2, BIG_ATT_END = BIG_VM + (size_t)MROWS * 256 * 2;
constexpr size_t BIG_XS = 0, BIG_HID = (size_t)PMAX_ROWS * 1024 * 2, BIG_MOE_END = BIG_HID + (size_t)PMAX_ROWS * 512 * 2;
constexpr size_t WS_SMALL = 478 * MiB;
constexpr size_t SM_NEGF = 0, SM_ROPE = SM_NEGF + (size_t)NB * 4 * LSEQ * 4, SM_TOKE = SM_ROPE + (size_t)4112 * 16 * 8, SM_TOKW = SM_TOKE + (size_t)MROWS * 8, SM_TOKP = SM_TOKW + (size_t)MROWS * 8,
                 SM_HMETA = SM_TOKP + (size_t)MROWS * 8, SM_ELIST = SM_HMETA + (size_t)NB * 16 * DM * 4, SM_RSL = SM_ELIST + (size_t)NEXP * MROWS * 4, SM_RSA = SM_RSL + (size_t)NEXP * MROWS * 4, SM_END = SM_RSA + (size_t)(NB * SEQ + NB * 16) * 4;
constexpr size_t WS_END = WS_SMALL + 12 * MiB;
static_assert(WS_W + 2 * W_LAYER <= WS_WMOE && WS_WMOE + WM_END <= WS_HB && WS_HB + (size_t)HB_ROWS * DM * 2 <= WS_XN, "weights / residual regions");
static_assert(WS_XN + (size_t)MROWS * DM * 2 <= WS_BIG, "xn region");
static_assert(WS_BIG + BIG_ATT_END <= WS_SMALL && WS_BIG + BIG_MOE_END <= WS_SMALL, "big region");
static_assert(SM_END <= 12 * MiB, "small region");
constexpr int CW_ATTQ = 64;
constexpr int CW_CNT = 256;
constexpr int CW_LATE = 512;
constexpr int CW_BAR = 4096;

constexpr int RING_BYTES = 131072;
constexpr int MISC_OFF = RING_BYTES;
constexpr int LDS_BYTES = 147456;

#define GAS __attribute__((address_space(1)))
#define LAS __attribute__((address_space(3)))
typedef unsigned short bf16_t;
typedef short bf16x8 __attribute__((ext_vector_type(8)));
typedef short s16x4 __attribute__((ext_vector_type(4)));
typedef float f32x4 __attribute__((ext_vector_type(4)));
typedef float f32x2 __attribute__((ext_vector_type(2)));
typedef float f32x16 __attribute__((ext_vector_type(16)));
typedef unsigned u32x4 __attribute__((ext_vector_type(4)));
typedef unsigned u32x2 __attribute__((ext_vector_type(2)));
typedef __bf16 bf16x2_t __attribute__((ext_vector_type(2)));

__device__ __forceinline__ unsigned cvtpk(float lo, float hi) { f32x2 v = {lo, hi}; bf16x2_t b = __builtin_convertvector(v, bf16x2_t); return __builtin_bit_cast(unsigned, b); }
__device__ __forceinline__ float bf_lo(unsigned w) { return __uint_as_float(w << 16); }
__device__ __forceinline__ float bf_hi(unsigned w) { return __uint_as_float(w & 0xffff0000u); }
__device__ __forceinline__ float bf2f(bf16_t v) { return __uint_as_float((unsigned)v << 16); }
__device__ __forceinline__ float shfl_xor_l(float v, int o, int lane) { return __int_as_float(__builtin_amdgcn_ds_bpermute(4 * (lane ^ o), __float_as_int(v))); }
__device__ __forceinline__ int shfl_up_l(int v, int o, int lane) { return __builtin_amdgcn_ds_bpermute(4 * (lane - o), v); }
__device__ __forceinline__ float swap_sum(float v) { auto rr = __builtin_amdgcn_permlane32_swap(__float_as_uint(v), __float_as_uint(v), false, false); return __uint_as_float(rr[0]) + __uint_as_float(rr[1]); }
__device__ __forceinline__ float swap_max(float v) { auto rr = __builtin_amdgcn_permlane32_swap(__float_as_uint(v), __float_as_uint(v), false, false); return fmaxf(__uint_as_float(rr[0]), __uint_as_float(rr[1])); }
__device__ __forceinline__ void swap_both(float v, float& from_lo, float& from_hi) { auto rr = __builtin_amdgcn_permlane32_swap(__float_as_uint(v), __float_as_uint(v), false, false); from_lo = __uint_as_float(rr[0]); from_hi = __uint_as_float(rr[1]); }
__device__ __forceinline__ int crow(int r, int hi) { return (r & 3) + 8 * (r >> 2) + 4 * hi; }

namespace pg8 {
constexpr int BM = 256, BK = 64, HALF = 128, HTB = HALF * BK * 2, STAGE_BYTES = 8 * HTB;
__host__ __device__ __forceinline__ int lds_byte(int r, int c) { const int st = (r >> 4) * 2 + (c >> 5), rr = r & 15, cc = c & 31, ob = rr * 64 + cc * 2; return st * 1024 + (ob ^ (((ob >> 9) & 1) << 5)); }
__host__ __device__ __forceinline__ void stage_rc(int b, int& R, int& C) { const int st = b / 1024, sb = b % 1024, swz = sb ^ (((sb >> 9) & 1) << 5); R = (st >> 1) * 16 + swz / 64; C = (st & 1) * 32 + (swz % 64) / 2; }
__host__ __device__ __forceinline__ int perm32(int rho) { const int n = rho >> 4, i = rho & 15; return 8 * (i >> 2) + 4 * n + (i & 3); }

struct Unit { const char* a; const char* b; int pm, pn; int e, r0; int row0; int nv; int late; };
struct Gemm { int lda, ldb, K; };

struct DenseOrder {
    static constexpr bool GATHER_CAPABLE = false; static constexpr bool PARTIAL = false;
    __device__ __forceinline__ void acquire_late(int) const {}
    __device__ __forceinline__ unsigned row_off(const Unit&, int) const { return 0u; }
    __device__ __forceinline__ void row_off4(const Unit&, const int (&)[4], unsigned (&off)[4]) const { off[0] = off[1] = off[2] = off[3] = 0u; }
    const char* A; const char* Bt; int lda, ldb; int nM, nN, nwg, G, c; bool areal;
    __device__ void init(const void* A_, const void* Bt_, int lda_, int ldb_, int M, int N, int G_, int c_, bool areal_) { areal = areal_; A = (const char*)A_; Bt = (const char*)Bt_; lda = lda_; ldb = ldb_; nM = NB * (SEQ / BM); (void)M; nN = N / BM; nwg = nM * nN; G = G_; c = c_; }
    __device__ bool next(int i, Unit& u) const {
        const long L = (long)i * G + c; if (L >= nwg) return false;
        int wgid = (int)L; { const int q = nwg / 8, r = nwg % 8, xcd = wgid % 8, off = wgid / 8; wgid = (xcd < r ? xcd * (q + 1) : r * (q + 1) + (xcd - r) * q) + off; }
        const int nig = 8 * nN, gid = wgid / nig, fm = gid * 8, gsz = (nM - fm) < 8 ? (nM - fm) : 8;
        u.pm = fm + ((wgid % nig) % gsz); u.pn = (wgid % nig) / gsz;
        u.e = 0; u.r0 = 0; u.nv = BM; u.late = 0; u.row0 = (u.pm >> 4) * LSEQ + 128 + ((u.pm & 15) << 8);
        u.a = A + (size_t)(areal ? u.pm * BM : u.row0) * lda * 2; u.b = Bt + (size_t)u.pn * BM * ldb * 2; return true;
    }
};
struct GroupedOrder {
    static constexpr bool GATHER_CAPABLE = true; static constexpr bool PARTIAL = true;
    const char* A; const char* Bt; int lda, ldb; size_t bstride; const volatile LAS int* tstart; int ntile, G, c; const int* elist; const unsigned* cnt; bool gather;
    __device__ __forceinline__ void row_off4(const Unit& u, const int (&r)[4], unsigned (&off)[4]) const { const int n = tstart[64 + u.e]; int tok[4];
#pragma unroll
        for (int k = 0; k < 4; ++k) { const int i = u.r0 + r[k]; tok[k] = elist[(size_t)u.e * MROWS + (i < n ? i : 0)]; }
#pragma unroll
        for (int k = 0; k < 4; ++k) off[k] = (unsigned)((u.r0 + r[k] < n) ? tok[k] : HB_ZERO) * (unsigned)(lda * 2); }
    __device__ __forceinline__ unsigned row_off(const Unit& u, int r) const { const int i = u.r0 + r; const int n = tstart[64 + u.e];
        const int tok = elist[(size_t)u.e * MROWS + (i < n ? i : 0)]; return (i < n) ? (unsigned)tok * (unsigned)(lda * 2) : 0u; }
    int mode; const unsigned* latecnt;
    __device__ __forceinline__ void acquire_late(int tid) const {
        if (tid == 0) { const int total = ntile * 4, L = total - (total / G) * G;
            while (__hip_atomic_load(latecnt, __ATOMIC_RELAXED, __HIP_MEMORY_SCOPE_AGENT) < (unsigned)L) __builtin_amdgcn_s_sleep(8);
            __builtin_amdgcn_fence(__ATOMIC_ACQUIRE, "agent"); asm volatile("s_waitcnt vmcnt(0)" ::: "memory"); } }
    __device__ __forceinline__ void fill(int idx, Unit& u) const {
        const int tile = idx >> 2, pn = idx & 3, nf = tstart[NEXP]; int e = 0;
        if (tile < nf) { for (int k = 1; k < NEXP; ++k) e += (tstart[k] <= tile) ? 1 : 0; u.r0 = (tile - tstart[e]) * BM; u.nv = BM; }
        else { e = tstart[128 + tile - nf]; u.r0 = (tstart[e + 1] - tstart[e]) * BM; u.nv = tstart[64 + e] & (BM - 1); }
        u.pm = tile; u.pn = pn; u.e = e; u.late = 0; u.row0 = tile * BM; u.a = gather ? A : A + (size_t)tile * BM * lda * 2; u.b = Bt + (size_t)e * bstride + (size_t)pn * BM * ldb * 2;
    }
    __device__ __forceinline__ bool next(int i, Unit& u) const {
        const int v0 = (G % 8 == 0) ? (c % 8) * (G / 8) + c / 8 : c;
        const int total = ntile * 4, R = total / G, L = total - R * G;
        if (mode == 0) { if (i >= R) return false; fill(i * G + ((i & 1) ? G - 1 - v0 : v0), u); return true; }
        if (mode == 1) { if (i > 0 || v0 >= L) return false; fill(R * G + v0, u); return true; }
        const bool late = v0 < L; const int slot = late ? G - L + v0 : v0 - L, NN = R * G;
        auto normal = [&](int t) -> int { const int r = late ? t + 2 : t; const int w = (r < 2) ? G - L : G, off = (r < 2) ? r * (G - L) : 2 * (G - L) + (r - 2) * G; const int n = off + slot; return (slot < w && n < NN) ? n : -1; };
        const int n = normal(i);
        if (n >= 0) { fill(n, u); return true; }
        if (late && (i == 0 || normal(i - 1) >= 0)) { fill(NN + v0, u); u.late = 1; return true; }
        return false;
    }
};

struct EpiBf16 {
    static constexpr bool PERM = true;
    bf16_t* O; int ldc;
    __device__ __forceinline__ void operator()(const f32x4 (&acc)[2][2][4][2], const Unit& u, int wr, int wc, int fr, int fq) const {
        const int row0 = u.row0 + wr * 64 + fr, col0 = u.pn * BM + wc * 32 + 8 * fq;
#pragma unroll
        for (int ai = 0; ai < 2; ++ai) { if (u.nv <= ai * HALF + wr * 64) continue;
#pragma unroll
            for (int m = 0; m < 4; ++m) { bf16_t* rowp = O + (size_t)(row0 + ai * HALF + m * 16) * ldc + col0;
#pragma unroll
                for (int bj = 0; bj < 2; ++bj) { const f32x4 v0 = acc[ai][bj][m][0], v1 = acc[ai][bj][m][1];
                    u32x4 w; w.x = cvtpk(v0[0], v0[1]); w.y = cvtpk(v0[2], v0[3]); w.z = cvtpk(v1[0], v1[1]); w.w = cvtpk(v1[2], v1[3]);
                    *(u32x4*)(rowp + bj * HALF) = w; } } }
    }
};
struct EpiProj {
    static constexpr bool PERM = true;
    bf16_t* O; int ldc; const float* rsa;
    __device__ __forceinline__ void operator()(const f32x4 (&acc)[2][2][4][2], const Unit& u, int wr, int wc, int fr, int fq) const {
        const int row0 = u.row0 + wr * 64 + fr, col0 = u.pn * BM + wc * 32 + 8 * fq;
        float rsv[2][4];
#pragma unroll
        for (int ai = 0; ai < 2; ++ai)
#pragma unroll
            for (int m = 0; m < 4; ++m) rsv[ai][m] = rsa[u.pm * BM + wr * 64 + fr + ai * HALF + m * 16];
        __builtin_amdgcn_sched_barrier(0);
#pragma unroll
        for (int ai = 0; ai < 2; ++ai)
#pragma unroll
            for (int m = 0; m < 4; ++m) { bf16_t* rowp = O + (size_t)(row0 + ai * HALF + m * 16) * ldc + col0; const float rs = rsv[ai][m];
#pragma unroll
                for (int bj = 0; bj < 2; ++bj) { const f32x4 v0 = acc[ai][bj][m][0], v1 = acc[ai][bj][m][1];
                    u32x4 w; w.x = cvtpk(v0[0] * rs, v0[1] * rs); w.y = cvtpk(v0[2] * rs, v0[3] * rs); w.z = cvtpk(v1[0] * rs, v1[1] * rs); w.w = cvtpk(v1[2] * rs, v1[3] * rs);
                    *(u32x4*)(rowp + bj * HALF) = w; } }
    }
};
struct EpiSwiGLU {
    static constexpr bool PERM = true;
    bf16_t* H; int ldc; const float* rsl;
    __device__ __forceinline__ void operator()(const f32x4 (&acc)[2][2][4][2], const Unit& u, int wr, int wc, int fr, int fq) const {
        const int row0 = u.row0 + wr * 64 + fr, col0 = u.pn * HALF + wc * 32 + 8 * fq;
        float rsv[2][4];
#pragma unroll
        for (int ai = 0; ai < 2; ++ai)
#pragma unroll
            for (int m = 0; m < 4; ++m) rsv[ai][m] = rsl[(size_t)u.e * MROWS + u.r0 + wr * 64 + fr + ai * HALF + m * 16];
        __builtin_amdgcn_sched_barrier(0);
#pragma unroll
        for (int ai = 0; ai < 2; ++ai) { if (u.nv <= ai * HALF + wr * 64) continue;
#pragma unroll
            for (int m = 0; m < 4; ++m) { bf16_t* rowp = H + (size_t)(row0 + ai * HALF + m * 16) * ldc + col0; float o[8];
#pragma unroll
                for (int n = 0; n < 2; ++n)
#pragma unroll
                    for (int k = 0; k < 4; ++k) { const float g = acc[ai][0][m][n][k] * rsv[ai][m], up = acc[ai][1][m][n][k] * rsv[ai][m]; o[n * 4 + k] = g * __builtin_amdgcn_rcpf(1.0f + __builtin_amdgcn_exp2f(-g * LOG2E)) * up; }
                u32x4 w; w.x = cvtpk(o[0], o[1]); w.y = cvtpk(o[2], o[3]); w.z = cvtpk(o[4], o[5]); w.w = cvtpk(o[6], o[7]);
                *(u32x4*)rowp = w; } }
    }
};
struct EpiResid {
    static constexpr bool PERM = true;
    bf16_t* out;
    __device__ __forceinline__ void operator()(const f32x4 (&acc)[2][2][4][2], const Unit& u, int wr, int wc, int fr, int fq) const {
        const int col0 = u.pn * BM + wc * 32 + 8 * fq;
        bf16_t* o0 = out + (size_t)(u.pm * BM + wr * 64 + fr) * DM + col0;
        u32x4 w[2][4][2];
#pragma unroll
        for (int ai = 0; ai < 2; ++ai)
#pragma unroll
            for (int m = 0; m < 4; ++m)
#pragma unroll
                for (int bj = 0; bj < 2; ++bj) w[ai][m][bj] = *(const u32x4*)(o0 + (size_t)(ai * HALF + m * 16) * DM + bj * HALF);
        __builtin_amdgcn_sched_barrier(0);
#pragma unroll
        for (int ai = 0; ai < 2; ++ai)
#pragma unroll
            for (int m = 0; m < 4; ++m)
#pragma unroll
                for (int bj = 0; bj < 2; ++bj) { const u32x4 b = w[ai][m][bj];
                    const f32x4 v0 = acc[ai][bj][m][0] + (f32x4){bf_lo(b.x), bf_hi(b.x), bf_lo(b.y), bf_hi(b.y)}, v1 = acc[ai][bj][m][1] + (f32x4){bf_lo(b.z), bf_hi(b.z), bf_lo(b.w), bf_hi(b.w)};
                    u32x4 o; o.x = cvtpk(v0[0], v0[1]); o.y = cvtpk(v0[2], v0[3]); o.z = cvtpk(v1[0], v1[1]); o.w = cvtpk(v1[2], v1[3]);
                    *(u32x4*)(o0 + (size_t)(ai * HALF + m * 16) * DM + bj * HALF) = o; }
    }
};

template <bool GATHER, class Epi, class Sched>
__device__ __forceinline__ void gemm_phase(int tid, LAS unsigned char* lds, const Gemm g, const Sched& S, const Epi& E) {
    const int wid = __builtin_amdgcn_readfirstlane(tid >> 6), lane = tid & 63, wr = wid >> 2, wc = wid & 3, fr = lane & 15, fq = lane >> 4;
    const int K = g.K, nt = K / BK;
    unsigned voffA0[2], voffA1[2], nA0[2], nA1[2], voffB[2];
    const size_t hstepB = (size_t)HALF * g.ldb * 2;
#pragma unroll
    for (int i = 0; i < 2; ++i) { int R, C; stage_rc(tid * 16 + i * 8192, R, C); const int Rb = Epi::PERM ? ((R & ~31) + perm32(R & 31)) : R;
        voffA0[i] = (unsigned)(R * g.lda + C) * 2u; voffA1[i] = voffA0[i] + (unsigned)(HALF * g.lda * 2); nA0[i] = voffA0[i]; nA1[i] = voffA1[i]; voffB[i] = (unsigned)(Rb * g.ldb + C) * 2u; }
    const size_t kstep = (size_t)(BK * 2);
    const unsigned ldsw = (unsigned)wid * 1024u;
    const int aoff = lds_byte(wr * 64 + fr, fq * 8), boff = lds_byte(wc * 32 + fr, fq * 8);
#define PG8_SA(b, h) (((b) * 2 + (h)) * HTB)
#define PG8_SB(b, h) ((4 + (b) * 2 + (h)) * HTB)
#define PG8_STAGE(bufoff, gbase, voff) do { _Pragma("unroll") for (int _i = 0; _i < 2; ++_i) \
        __builtin_amdgcn_global_load_lds((const unsigned*)((const char*)(gbase) + (voff)[_i]), (LAS unsigned*)(lds + (bufoff) + ldsw + _i * 8192), 16, 0, 0); } while (0)
#define PG8_LDA(dst, b, h) do { _Pragma("unroll") for (int m = 0; m < 4; ++m) _Pragma("unroll") for (int k = 0; k < 2; ++k) dst[m][k] = *(const LAS bf16x8*)(lds + PG8_SA(b, h) + aoff + m * 2048 + k * 1024); } while (0)
#define PG8_LDB(dst, b, h) do { _Pragma("unroll") for (int n = 0; n < 2; ++n) _Pragma("unroll") for (int k = 0; k < 2; ++k) dst[n][k] = *(const LAS bf16x8*)(lds + PG8_SB(b, h) + boff + n * 2048 + k * 1024); } while (0)
#define PG8_MMA(ai, bj, At, Bt) do { __builtin_amdgcn_s_setprio(1); _Pragma("unroll") for (int m = 0; m < 4; ++m) _Pragma("unroll") for (int n = 0; n < 2; ++n) _Pragma("unroll") for (int k = 0; k < 2; ++k) \
        acc[ai][bj][m][n] = __builtin_amdgcn_mfma_f32_16x16x32_bf16(Bt[n][k], At[m][k], acc[ai][bj][m][n], 0, 0, 0); __builtin_amdgcn_s_setprio(0); } while (0)
#define PG8_WAIT_V(n) asm volatile("s_waitcnt vmcnt(" #n ")" ::: "memory")
#define PG8_WAIT_V8_UNLESS(c) asm volatile("s_cmp_lg_u32 %0, 0\n\ts_cbranch_scc1 1f\n\ts_waitcnt vmcnt(8)\n1:" :: "s"(c) : "memory", "scc")
#define PG8_WAIT_L(n) asm volatile("s_waitcnt lgkmcnt(" #n ")" ::: "memory")
#define PG8_BAR __builtin_amdgcn_s_barrier()
#define PG8_SCHED __builtin_amdgcn_sched_barrier(0)
    Unit cur, nxt; int ui = 0;
    if (!S.next(0, cur)) return;
    if (Sched::PARTIAL && cur.late) { S.acquire_late(tid); __syncthreads(); }
    f32x4 acc[2][2][4][2];
#pragma unroll
    for (int a = 0; a < 2; ++a)
#pragma unroll
        for (int b = 0; b < 2; ++b)
#pragma unroll
            for (int m = 0; m < 4; ++m)
#pragma unroll
                for (int n = 0; n < 2; ++n) acc[a][b][m][n] = (f32x4){0.f, 0.f, 0.f, 0.f};
    bf16x8 At[4][2], B0[2][2], B1[2][2];
    const char* cA = cur.a; const char* cB = cur.b;
    if (GATHER) { int RA[2], CA[2]; { int tl_ = tid; asm volatile("" : "+v"(tl_)); stage_rc(tl_ * 16, RA[0], CA[0]); stage_rc(tl_ * 16 + 8192, RA[1], CA[1]); }     const int r4[4] = {RA[0], RA[1], HALF + RA[0], HALF + RA[1]}; unsigned o4[4]; S.row_off4(cur, r4, o4);
        voffA0[0] = o4[0] + (unsigned)(CA[0] * 2); voffA0[1] = o4[1] + (unsigned)(CA[1] * 2); voffA1[0] = o4[2] + (unsigned)(CA[0] * 2); voffA1[1] = o4[3] + (unsigned)(CA[1] * 2); }
    PG8_STAGE(PG8_SB(0, 0), cB, voffB); PG8_STAGE(PG8_SB(0, 1), cB + hstepB, voffB); PG8_STAGE(PG8_SA(0, 0), cA, voffA0); PG8_STAGE(PG8_SA(0, 1), cA, voffA1);
    if (wr == 1) PG8_BAR;
    PG8_WAIT_V(2); PG8_BAR;
    PG8_STAGE(PG8_SB(1, 0), cB + kstep, voffB); PG8_STAGE(PG8_SA(1, 0), cA + kstep, voffA0); PG8_STAGE(PG8_SB(1, 1), cB + hstepB + kstep, voffB);
    PG8_WAIT_V(6); PG8_BAR;
    for (;;) {
        const bool has_next = S.next(ui + 1, nxt);
        if (Sched::PARTIAL && has_next && nxt.late) S.acquire_late(tid);
        const char* nA = has_next ? nxt.a : cA; const char* nB = has_next ? nxt.b : cB;
        if (GATHER) { if (has_next) { int RA[2], CA[2]; { int tl_ = tid; asm volatile("" : "+v"(tl_)); stage_rc(tl_ * 16, RA[0], CA[0]); stage_rc(tl_ * 16 + 8192, RA[1], CA[1]); }     const int r4[4] = {RA[0], RA[1], HALF + RA[0], HALF + RA[1]}; unsigned o4[4]; S.row_off4(nxt, r4, o4);
                nA0[0] = o4[0] + (unsigned)(CA[0] * 2); nA0[1] = o4[1] + (unsigned)(CA[1] * 2); nA1[0] = o4[2] + (unsigned)(CA[0] * 2); nA1[1] = o4[3] + (unsigned)(CA[1] * 2); }
            else { nA0[0] = voffA0[0]; nA0[1] = voffA0[1]; nA1[0] = voffA1[0]; nA1[1] = voffA1[1]; } }
        constexpr bool act0 = true, act1 = true;
        for (int t = 0; t < nt; t += 2) {
            const bool last = (t == nt - 2); const int fresh = __builtin_amdgcn_readfirstlane((t == 0 && ui > 0) ? 1 : 0);
            const char* a1 = cA + (size_t)(t + 1) * kstep;
            const char* a2 = last ? nA : cA + (size_t)(t + 2) * kstep; const char* b2 = last ? nB : cB + (size_t)(t + 2) * kstep;
            const char* a3 = a2 + kstep; const char* b3 = b2 + kstep;
            unsigned x0[2], x1[2];
#pragma unroll
            for (int i = 0; i < 2; ++i) { x0[i] = (GATHER && last) ? nA0[i] : voffA0[i]; x1[i] = (GATHER && last) ? nA1[i] : voffA1[i]; }
            PG8_LDB(B0, 0, 0); PG8_LDB(B1, 0, 1); PG8_SCHED; PG8_LDA(At, 0, 0); PG8_STAGE(PG8_SA(1, 1), a1, voffA1);
            PG8_WAIT_V8_UNLESS(fresh); PG8_WAIT_L(0); PG8_BAR; if (act0) { PG8_MMA(0, 0, At, B0); PG8_MMA(0, 1, At, B1); } PG8_BAR; PG8_SCHED;
            PG8_LDA(At, 0, 1); PG8_STAGE(PG8_SB(0, 0), b2, voffB); PG8_STAGE(PG8_SB(0, 1), b2 + hstepB, voffB); PG8_STAGE(PG8_SA(0, 0), a2, x0);
            PG8_WAIT_V8_UNLESS(fresh); PG8_WAIT_L(0); PG8_BAR; if (act1) { PG8_MMA(1, 0, At, B0); PG8_MMA(1, 1, At, B1); } PG8_BAR; PG8_SCHED;
            PG8_LDB(B0, 1, 0); PG8_LDB(B1, 1, 1); PG8_SCHED; PG8_LDA(At, 1, 0); PG8_STAGE(PG8_SA(0, 1), a2, x1);
            PG8_WAIT_V(8); PG8_WAIT_L(0); PG8_BAR; if (act0) { PG8_MMA(0, 0, At, B0); PG8_MMA(0, 1, At, B1); } PG8_BAR; PG8_SCHED;
            PG8_LDA(At, 1, 1); PG8_STAGE(PG8_SB(1, 0), b3, voffB); PG8_STAGE(PG8_SB(1, 1), b3 + hstepB, voffB); PG8_STAGE(PG8_SA(1, 0), a3, x0);
            PG8_WAIT_V(8); PG8_WAIT_L(0); PG8_BAR; if (act1) { PG8_MMA(1, 0, At, B0); PG8_MMA(1, 1, At, B1); } PG8_BAR; PG8_SCHED;
        }
        PG8_WAIT_V(0);
        if (wr == 0) PG8_BAR;
        E(acc, cur, wr, wc, fr, fq);
        if (!has_next) break;
#pragma unroll
        for (int a = 0; a < 2; ++a)
#pragma unroll
            for (int b = 0; b < 2; ++b)
#pragma unroll
                for (int m = 0; m < 4; ++m)
#pragma unroll
                    for (int n = 0; n < 2; ++n) acc[a][b][m][n] = (f32x4){0.f, 0.f, 0.f, 0.f};
        cur = nxt; cA = nA; cB = nB; ++ui;
        if (GATHER) {
#pragma unroll
            for (int i = 0; i < 2; ++i) { voffA0[i] = nA0[i]; voffA1[i] = nA1[i]; } }
        if (wr == 1) PG8_BAR;
    }
    PG8_WAIT_V(0);
    PG8_BAR;
#undef PG8_SA
#undef PG8_SB
#undef PG8_STAGE
#undef PG8_LDA
#undef PG8_LDB
#undef PG8_MMA
#undef PG8_WAIT_V
#undef PG8_WAIT_L
#undef PG8_BAR
#undef PG8_SCHED
}
}

struct Args {
    const float* in[20]; float* out; unsigned char* ws; int ph_lo, ph_hi;
};
struct Frame {
    LAS unsigned char* lds; volatile LAS int* MISC;
    int tid, lane, wave, G, gw, NGW;
};

__constant__ float INV_FREQ[16] = {1.0f, 0.5623413251903491f, 0.31622776601683794f, 0.1778279410038923f, 0.1f, 0.05623413251903491f, 0.03162277660168379f, 0.01778279410038923f,
                                   0.01f, 0.005623413251903491f, 0.003162277660168379f, 0.001778279410038923f, 0.001f, 0.0005623413251903491f, 0.00031622776601683794f, 0.00017782794100389227f};

__device__ __forceinline__ void transpose_item(const float* W, int N, int k0, int scol0, int nvalid, const float* kscale, bf16_t* WT, int K, int drow0, LAS float* scr, int lane) {
    const int j = lane & 31;
    if (nvalid == 0) {
#pragma unroll
        for (int i = 0; i < 32; ++i) scr[(2 * i + (lane >> 5)) * 33 + j] = 0.f;
    } else {
        const int jc = j < nvalid ? j : 0;
        const float* src = W + (size_t)(k0 + (lane >> 5)) * N + scol0 + jc;
        float t[32];
#pragma unroll
        for (int i = 0; i < 32; ++i) t[i] = src[(size_t)(2 * i) * N];
#pragma unroll
        for (int i = 0; i < 32; ++i) { const int kk = 2 * i + (lane >> 5); float v = (j < nvalid) ? t[i] : 0.f; if (kscale) v *= kscale[k0 + kk]; scr[kk * 33 + j] = v; }
    }
    asm volatile("s_waitcnt lgkmcnt(0)" ::: "memory");
    const int c = lane & 7;
#pragma unroll
    for (int q = 0; q < 4; ++q) { const int n = (lane >> 3) + 8 * q; const LAS float* s = scr + (8 * c) * 33 + n;
        u32x4 o; o.x = cvtpk(s[0 * 33], s[1 * 33]); o.y = cvtpk(s[2 * 33], s[3 * 33]); o.z = cvtpk(s[4 * 33], s[5 * 33]); o.w = cvtpk(s[6 * 33], s[7 * 33]);
        *(u32x4*)(WT + (size_t)(drow0 + n) * K + k0 + 8 * c) = o; }
    asm volatile("s_waitcnt lgkmcnt(0)" ::: "memory");
}
template <class Map>
__device__ __forceinline__ void transpose_matrix(Frame& F, int& base, int it, const float* W, int K, int N, int Ndst, const float* kscale, bf16_t* WT, const Map& map, LAS float* scr, bool& done) {
    const int nblk = Ndst / 32, items = (K / 64) * nblk;
    if (!done && it >= base && it < base + items) { const int r = it - base, kb = r / nblk, nb = r % nblk; int scol0, nvalid, drow0; map(nb, scol0, nvalid, drow0);
        transpose_item(W, N, 64 * kb, scol0, nvalid, kscale, WT, K, drow0, scr, F.lane); done = true; }
    base += items;
}


struct XwItem { const float* src; int N; int k0; int scol; bf16_t* dst; int K; int drow0; const float* gain; };
__device__ __forceinline__ XwItem xw_decode(int it, const float* wg, const float* wu, const float* wd, const float* gain, bf16_t* gu_t, bf16_t* dn_t) {
    constexpr int per_gu = (1024 / 64) * (1024 / 32), items_gu = NEXP * per_gu, per_dn = (512 / 64) * (1024 / 32);
    XwItem x;
    if (it < items_gu) { const int e = it / per_gu, q = it % per_gu, kb = q / 32, nb = q % 32;
        const int pn = nb >> 3, within = nb & 7; const bool up = within >= 4;
        x.src = (up ? wu : wg) + (size_t)e * 1024 * 512; x.N = 512; x.k0 = 64 * kb; x.scol = 128 * pn + 32 * (within & 3); x.dst = gu_t + (size_t)e * 1024 * 1024; x.K = 1024; x.drow0 = 32 * nb; x.gain = gain; }
    else { const int r = it - items_gu, e = r / per_dn, q = r % per_dn, kb = q / 32, nb = q % 32;
        x.src = wd + (size_t)e * 512 * 1024; x.N = 1024; x.k0 = 64 * kb; x.scol = 32 * nb; x.dst = dn_t + (size_t)e * 1024 * 512; x.K = 512; x.drow0 = 32 * nb; x.gain = nullptr; }
    return x;
}
__device__ __forceinline__ void xw_load(const XwItem& x, int lane, float (&t)[32]) {
    const float* src = x.src + (size_t)(x.k0 + (lane >> 5)) * x.N + x.scol + (lane & 31);
#pragma unroll
    for (int i = 0; i < 32; ++i) t[i] = __builtin_nontemporal_load(src + (size_t)(2 * i) * x.N);
}
__device__ __forceinline__ void xw_finish(const XwItem& x, int lane, const float (&t)[32], LAS float* scr) {
    const int j = lane & 31, c = lane & 7;
    f32x4 g0 = {1.f, 1.f, 1.f, 1.f}, g1 = g0;
    if (x.gain) { g0 = *(const f32x4*)(x.gain + x.k0 + 8 * c); g1 = *(const f32x4*)(x.gain + x.k0 + 8 * c + 4); }
#pragma unroll
    for (int i = 0; i < 32; ++i) scr[(2 * i + (lane >> 5)) * 33 + j] = t[i];
    asm volatile("s_waitcnt lgkmcnt(0)" ::: "memory");
#pragma unroll
    for (int q = 0; q < 4; ++q) { const int n = (lane >> 3) + 8 * q; const LAS float* sp = scr + (8 * c) * 33 + n;
        u32x4 o; o.x = cvtpk(sp[0 * 33] * g0[0], sp[1 * 33] * g0[1]); o.y = cvtpk(sp[2 * 33] * g0[2], sp[3 * 33] * g0[3]); o.z = cvtpk(sp[4 * 33] * g1[0], sp[5 * 33] * g1[1]); o.w = cvtpk(sp[6 * 33] * g1[2], sp[7 * 33] * g1[3]);
        *(u32x4*)(x.dst + (size_t)(x.drow0 + n) * x.K + x.k0 + 8 * c) = o; }
    asm volatile("s_waitcnt lgkmcnt(0)" ::: "memory");
}
constexpr int XW_ITEMS = NEXP * ((1024 / 64) * (1024 / 32) + (512 / 64) * (1024 / 32)), XW_PER_WAVE = 12, XW_WG_ITEMS = XW_ITEMS / (NWAVES * XW_PER_WAVE);
static_assert(XW_WG_ITEMS * NWAVES * XW_PER_WAVE == XW_ITEMS, "expert conversion items");
__device__ __forceinline__ void xw_wg_item(int q, int wave, int lane, const float* wg, const float* wu, const float* wd, const float* gain, bf16_t* gu_t, bf16_t* dn_t, LAS float* scr) {
    const int it0 = (q * NWAVES + wave) * XW_PER_WAVE;
    float ta[32], tb[32];
    XwItem xa = xw_decode(it0, wg, wu, wd, gain, gu_t, dn_t), xb = xa;
    xw_load(xa, lane, ta);
#pragma unroll 1
    for (int k = 0; k < XW_PER_WAVE; k += 2) {
        xb = xw_decode(it0 + k + 1, wg, wu, wd, gain, gu_t, dn_t); xw_load(xb, lane, tb);
        xw_finish(xa, lane, ta, scr);
        if (k + 2 < XW_PER_WAVE) { xa = xw_decode(it0 + k + 2, wg, wu, wd, gain, gu_t, dn_t); xw_load(xa, lane, ta); }
        xw_finish(xb, lane, tb, scr);
    }
}

__device__ __forceinline__ float* hrow_ptr(float* out_real, float* h_meta, int m) { const int b = m / LSEQ, p = m - b * LSEQ; return p < 128 ? h_meta + (size_t)(b * 16 + (p - PADF)) * DM : out_real + (size_t)(b * SEQ + (p - 128)) * DM; }

__device__ __forceinline__ void store_xn_row(bf16_t* orow, const f32x4 (&v)[4], float rs, const f32x4 (&gg)[4], int lane) {
    u32x2* o8 = (u32x2*)orow + lane;
#pragma unroll
    for (int j = 0; j < 4; ++j) { u32x2 w; w.x = cvtpk(v[j].x * rs * gg[j].x, v[j].y * rs * gg[j].y); w.y = cvtpk(v[j].z * rs * gg[j].z, v[j].w * rs * gg[j].w); o8[64 * j] = w; }
}
__device__ __forceinline__ void zero_xn_row(bf16_t* orow, int lane) { u32x2* o8 = (u32x2*)orow + lane;
#pragma unroll
    for (int j = 0; j < 4; ++j) o8[64 * j] = (u32x2){0u, 0u}; }

__device__ __forceinline__ void moe_combine_row(f32x4 (&v)[4], const bf16_t* yrows, const int* tokp, const float* tokw, int m, int lane) {
    const int s0 = tokp[2 * m], s1 = tokp[2 * m + 1]; const float w0 = tokw[2 * m], w1 = tokw[2 * m + 1];
    const u32x2* y0 = (const u32x2*)(yrows + (size_t)s0 * DM) + lane; const u32x2* y1 = (const u32x2*)(yrows + (size_t)s1 * DM) + lane;
#pragma unroll
    for (int j = 0; j < 4; ++j) { const u32x2 a = y0[64 * j], b = y1[64 * j];
        v[j].x += w0 * bf_lo(a.x) + w1 * bf_lo(b.x); v[j].y += w0 * bf_hi(a.x) + w1 * bf_hi(b.x); v[j].z += w0 * bf_lo(a.y) + w1 * bf_lo(b.y); v[j].w += w0 * bf_hi(a.y) + w1 * bf_hi(b.y); }
}


struct NormCtx { const float* x; const float* meta; float* out; float* hmeta; bf16_t* hb; const float* g; float* rsa; const bf16_t* yrows; const int* toke; const int* tokp; const float* tokw; const volatile LAS int* tstart; };
template <int MODE, int NR>
__device__ __forceinline__ void norm_rows(const NormCtx& C, int m0, int mend, int lane) {
    f32x4 v[NR][4]; bool valid[NR]; float* hp[NR]; bf16_t* hbp[NR];
    f32x4 gg[4];
    if (MODE == 2) {
#pragma unroll
        for (int j = 0; j < 4; ++j) gg[j] = *((const f32x4*)C.g + lane + 64 * j); }
#pragma unroll
    for (int r = 0; r < NR; ++r) { const int m = m0 + r; valid[r] = false; hp[r] = nullptr; hbp[r] = nullptr;
        if (m < mend) {
            if (MODE == 2) { valid[r] = true; hp[r] = C.out + (size_t)m * DM; hbp[r] = C.hb + (size_t)m * DM; }
            else { const int b = m / LSEQ, p = m - b * LSEQ; valid[r] = (p >= PADF);
                if (valid[r]) { if (MODE == 0) hp[r] = (float*)(p < 128 ? C.meta + (size_t)(p - PADF) * DM : C.x + (size_t)(b * SEQ + p - 128) * DM);
                    else if (p < 128) hp[r] = C.hmeta + (size_t)(b * 16 + (p - PADF)) * DM; else hbp[r] = C.hb + (size_t)(b * SEQ + (p - 128)) * DM; } }
            if (valid[r]) {
                if (hbp[r]) { const u32x2* xr = (const u32x2*)hbp[r] + lane;
#pragma unroll
                    for (int j = 0; j < 4; ++j) { const u32x2 w = xr[64 * j]; v[r][j] = (f32x4){bf_lo(w.x), bf_hi(w.x), bf_lo(w.y), bf_hi(w.y)}; } }
                else { const f32x4* xr = (const f32x4*)hp[r] + lane;
#pragma unroll
                    for (int j = 0; j < 4; ++j) v[r][j] = __builtin_nontemporal_load(xr + 64 * j); } }
        } }
    if (MODE == 0) {
#pragma unroll
        for (int r = 0; r < NR; ++r) { const int m = m0 + r; const int b = m / LSEQ, p = m - b * LSEQ;
            if (m < mend && p >= PADF) { u32x2* hr = (u32x2*)(C.hb + (size_t)(p >= 128 ? b * SEQ + (p - 128) : HB_META + b * 16 + (p - PADF)) * DM) + lane;
#pragma unroll
                for (int j = 0; j < 4; ++j) hr[64 * j] = (u32x2){cvtpk(v[r][j].x, v[r][j].y), cvtpk(v[r][j].z, v[r][j].w)}; } }
    }
    if (MODE == 1 || MODE == 2) {
        u32x2 ya[NR][4], yb[NR][4]; float w0[NR], w1[NR]; int e0[NR], e1[NR], q0[NR], q1[NR];
#pragma unroll
        for (int r = 0; r < NR; ++r) { e0[r] = e1[r] = q0[r] = q1[r] = 0; w0[r] = w1[r] = 0.f;
            if (valid[r]) { int mt = m0 + r; if (MODE == 2) { const int b = mt / SEQ; mt = b * LSEQ + 128 + (mt - b * SEQ); }
                e0[r] = C.toke[2 * mt]; e1[r] = C.toke[2 * mt + 1]; q0[r] = C.tokp[2 * mt]; q1[r] = C.tokp[2 * mt + 1]; w0[r] = C.tokw[2 * mt]; w1[r] = C.tokw[2 * mt + 1]; } }
#pragma unroll
        for (int r = 0; r < NR; ++r) if (valid[r]) {
            const int f0 = (C.tstart[e0[r] + 1] - C.tstart[e0[r]]) * 256, f1 = (C.tstart[e1[r] + 1] - C.tstart[e1[r]]) * 256;
            const int s0 = q0[r] < f0 ? C.tstart[e0[r]] * 256 + q0[r] : C.tstart[96 + e0[r]] * 256 + (q0[r] - f0), s1 = q1[r] < f1 ? C.tstart[e1[r]] * 256 + q1[r] : C.tstart[96 + e1[r]] * 256 + (q1[r] - f1);
            const u32x2* y0 = (const u32x2*)(C.yrows + (size_t)s0 * DM) + lane; const u32x2* y1 = (const u32x2*)(C.yrows + (size_t)s1 * DM) + lane;
#pragma unroll
            for (int j = 0; j < 4; ++j) { ya[r][j] = __builtin_nontemporal_load(y0 + 64 * j); yb[r][j] = __builtin_nontemporal_load(y1 + 64 * j); } }
#pragma unroll
        for (int r = 0; r < NR; ++r) if (valid[r]) {
#pragma unroll
            for (int j = 0; j < 4; ++j) { const u32x2 a = ya[r][j], b = yb[r][j];
                v[r][j].x += w0[r] * bf_lo(a.x) + w1[r] * bf_lo(b.x); v[r][j].y += w0[r] * bf_hi(a.x) + w1[r] * bf_hi(b.x); v[r][j].z += w0[r] * bf_lo(a.y) + w1[r] * bf_lo(b.y); v[r][j].w += w0[r] * bf_hi(a.y) + w1[r] * bf_hi(b.y); }
            if (MODE == 1) {
                if (hbp[r]) { u32x2* hr = (u32x2*)hbp[r] + lane;
#pragma unroll
                    for (int j = 0; j < 4; ++j) hr[64 * j] = (u32x2){cvtpk(v[r][j].x, v[r][j].y), cvtpk(v[r][j].z, v[r][j].w)}; }
                else { f32x4* hr = (f32x4*)hp[r] + lane; const int mm = m0 + r, bb = mm / LSEQ, pp = mm - bb * LSEQ; u32x2* hc = (u32x2*)(C.hb + (size_t)(HB_META + bb * 16 + (pp - PADF)) * DM) + lane;
#pragma unroll
                    for (int j = 0; j < 4; ++j) { hr[64 * j] = v[r][j]; hc[64 * j] = (u32x2){cvtpk(v[r][j].x, v[r][j].y), cvtpk(v[r][j].z, v[r][j].w)}; } } } }
    }
    float ss[NR];
#pragma unroll
    for (int r = 0; r < NR; ++r) { ss[r] = 0.f; if (valid[r]) {
#pragma unroll
        for (int j = 0; j < 4; ++j) ss[r] += (v[r][j].x * v[r][j].x + v[r][j].y * v[r][j].y) + (v[r][j].z * v[r][j].z + v[r][j].w * v[r][j].w); } }
#pragma unroll
    for (int o = 1; o < 64; o <<= 1) {
#pragma unroll
        for (int r = 0; r < NR; ++r) ss[r] += shfl_xor_l(ss[r], o, lane); }
#pragma unroll
    for (int r = 0; r < NR; ++r) { const int m = m0 + r; if (m >= mend) continue;
        const float rs = __builtin_amdgcn_rsqf(ss[r] * (1.0f / DM) + EPS);
        if (MODE == 2) { f32x4* hr = (f32x4*)hp[r] + lane;
#pragma unroll
            for (int j = 0; j < 4; ++j) __builtin_nontemporal_store((f32x4){v[r][j].x * rs * gg[j].x, v[r][j].y * rs * gg[j].y, v[r][j].z * rs * gg[j].z, v[r][j].w * rs * gg[j].w}, hr + 64 * j); }
        else if (valid[r] && lane == 0) { const int b = m / LSEQ, p = m - b * LSEQ; C.rsa[p >= 128 ? b * SEQ + (p - 128) : NB * SEQ + b * 16 + (p - PADF)] = rs; } }
}

constexpr int AT_KP = 208;
constexpr int AT_KBUF = 64 * AT_KP, AT_VBUF = 8192, AT_FBUF = 256;
constexpr int AT_K0 = 0, AT_V0 = 4 * AT_KBUF, AT_F0 = AT_V0 + 4 * AT_VBUF, AT_END = AT_F0 + 4 * AT_FBUF;
static_assert(AT_END + 64 <= RING_BYTES, "attention LDS (+ 2 x 8 wave flags)");
struct AttnArgs { const bf16_t* proj; const bf16_t* qm; const bf16_t* km; const bf16_t* vm; const float* negf; const float* sinks; bf16_t* y; };

template <int VAR>
__device__ __forceinline__ void attn_unit(int tid, const AttnArgs& T, int b, int h, int u, LAS unsigned char* lds) {
    constexpr int DK = (VAR == 2) ? 96 : 64, NDS = DK / 16, KCH = DK / 8, KPB = DK * 2 + 16;
    const int lane = tid & 63, rr = lane & 31, hi = lane >> 5; const int wid = __builtin_amdgcn_readfirstlane(tid >> 6);
    const bf16_t *Qb, *Kb, *Vb; int qpitch, kpitch, vpitch;
    if (VAR == 0) { Qb = T.proj + C_AQ + 64 * h; Kb = T.proj + C_AK + 64 * (h >> 1); Vb = T.proj + C_AV + 64 * (h >> 1); qpitch = kpitch = vpitch = NPROJ; }
    else if (VAR == 1) { Qb = T.proj + C_FQ + 64 * h; Kb = T.proj + C_FK + 64 * h; Vb = T.proj + C_FV + 64 * h; qpitch = kpitch = vpitch = NPROJ; }
    else if (VAR == 2) { Qb = T.qm + 96 * h; Kb = T.km + 96 * h; Vb = T.vm + 64 * h; qpitch = kpitch = 384; vpitch = 256; }
    else { Qb = T.proj + C_SQ + 64 * h; Kb = T.proj + C_SK + 64 * h; Vb = T.proj + C_SV + 64 * h; qpitch = kpitch = vpitch = NPROJ; }
    const size_t rowb = (size_t)b * LSEQ;
    const int pq0 = (u < 0 ? -128 : 128 + 256 * u) + 32 * wid;
    const int pq = pq0 + rr;
    const bool wave_on = (pq0 + 31 >= PADF);
    const int cq = (u < 0) ? 0 : 4 * u + 1 + (wid >> 1);
    int ntile, t_first, t_step;
    if (u < 0) { ntile = 1; t_first = 1; t_step = 1; }
    else if (VAR == 0) { t_first = (u == 0) ? 2 : 4 * u; ntile = 4 * u + 5 - t_first + 2; t_step = 1; }
    else if (VAR == 3 || VAR == 1) { ntile = 4 * u + 5; t_first = 4 * u + 5; t_step = -1; }
    else { ntile = 4 * u + 5; t_first = 1; t_step = 1; }
#define TILE_OF(i) ((VAR == 0 && u >= 0) ? ((i) == 0 ? 1 : t_first + (i) - 1) : t_first + t_step * (i))
    bf16x8 qf[NDS];
    { const int pl = pq < 0 ? 0 : pq; const bf16_t* qrow = Qb + (rowb + pl) * qpitch + 8 * hi;
#pragma unroll
      for (int ds = 0; ds < NDS; ++ds) qf[ds] = *(const bf16x8*)(qrow + 16 * ds); }
    const int kr0 = tid / KCH, kc0 = tid % KCH;
    const int kr1 = (tid + 512) / KCH, kc1 = (tid + 512) % KCH;
    const bool k2 = (DK == 96) && (tid < 256);
    const int vr = tid >> 3, vc = tid & 7;
    const int v_lds = (vr >> 3) * 1024 + (vc >> 2) * 512 + (vr & 7) * 64 + (vc & 3) * 16;
    u32x4 kreg0a, kreg1a, vrega, kreg0b, kreg1b, vregb; f32x4 frega, fregb;
    kreg1a = (u32x4){0u, 0u, 0u, 0u}; kreg1b = kreg1a; frega = (f32x4){0.f, 0.f, 0.f, 0.f}; fregb = frega;
#define AT_LOAD(S_, j) do { const size_t r0_ = rowb + 64 * (size_t)(j); \
        kreg0##S_ = *(const u32x4*)(Kb + (r0_ + kr0) * kpitch + 8 * kc0); if (k2) kreg1##S_ = *(const u32x4*)(Kb + (r0_ + kr1) * kpitch + 8 * kc1); \
        vreg##S_ = *(const u32x4*)(Vb + (r0_ + vr) * vpitch + 8 * vc); \
        if (VAR == 1 && tid < 16) freg##S_ = *(const f32x4*)(T.negf + ((size_t)(b * 4 + h) * LSEQ + 64 * (j)) + 4 * tid); } while (0)
#define AT_WRITE(S_, buf) do { *(LAS u32x4*)(lds + AT_K0 + (buf) * AT_KBUF + kr0 * KPB + kc0 * 16) = kreg0##S_; if (k2) *(LAS u32x4*)(lds + AT_K0 + (buf) * AT_KBUF + kr1 * KPB + kc1 * 16) = kreg1##S_; \
        *(LAS u32x4*)(lds + AT_V0 + (buf) * AT_VBUF + v_lds) = vreg##S_; if (VAR == 1 && tid < 16) *(LAS f32x4*)(lds + AT_F0 + (buf) * AT_FBUF + 16 * tid) = freg##S_; } while (0)
    constexpr float ATT_THR = 8.0f;
    const float cs = ((VAR == 2) ? 0.10206207261596575f : 0.125f) * LOG2E;
#pragma unroll
    for (int ds = 0; ds < NDS; ++ds) { u32x4 w = __builtin_bit_cast(u32x4, qf[ds]);
#pragma unroll
        for (int k = 0; k < 4; ++k) w[k] = cvtpk(bf_lo(w[k]) * cs, bf_hi(w[k]) * cs);
        qf[ds] = __builtin_bit_cast(bf16x8, w); }
    float mhat = 0.f, l_run = 0.f, R_run = 1.0f, slope2 = 0.f; bool wave_dead = false;
    if (VAR == 0) { l_run = (hi == 0) ? __builtin_amdgcn_exp2f(T.sinks[h] * LOG2E) : 0.f; slope2 = __builtin_amdgcn_exp2f(-2.0f * (float)(h + 1)) * LOG2E; }
    f32x16 o0 = {}, o1 = {};
    const int vbase = (4 * hi + ((lane & 15) >> 2)) * 64 + ((lane >> 4) & 1) * 32 + (lane & 3) * 8;
    AT_LOAD(a, TILE_OF(0)); if (ntile > 1) AT_LOAD(b, TILE_OF(1));
    AT_WRITE(a, 0); if (ntile > 1) AT_WRITE(b, 1);
    __syncthreads();
    auto compute_tile = [&](const int j, const int buf) __attribute__((always_inline)) {
        const int cj = j - 1;
        bool doit = wave_on && (cj <= cq) && !wave_dead;
        if (VAR == 0) doit = doit && (j == 1 || cj >= cq - 2);
        if (doit) {
            const LAS unsigned char* Kt = lds + AT_K0 + buf * AT_KBUF; const LAS unsigned char* Vt = lds + AT_V0 + buf * AT_VBUF;
            f32x16 p0, p1;
            { const float nm = (VAR == 3) ? 0.f : -mhat;
#pragma unroll
              for (int r = 0; r < 16; ++r) { p0[r] = nm; p1[r] = nm; } }
            { bf16x8 kf[2 * NDS];
#pragma unroll
              for (int ds = 0; ds < NDS; ++ds) { kf[2 * ds] = *(const LAS bf16x8*)(Kt + rr * KPB + (2 * ds + hi) * 16); kf[2 * ds + 1] = *(const LAS bf16x8*)(Kt + (32 + rr) * KPB + (2 * ds + hi) * 16); }
              __builtin_amdgcn_sched_group_barrier(0x100, 2 * NDS, 0);
#pragma unroll
              for (int ds = 0; ds < NDS; ++ds) {
                p0 = __builtin_amdgcn_mfma_f32_32x32x16_bf16(kf[2 * ds], qf[ds], p0, 0, 0, 0);
                p1 = __builtin_amdgcn_mfma_f32_32x32x16_bf16(kf[2 * ds + 1], qf[ds], p1, 0, 0, 0);
              }
              __builtin_amdgcn_sched_group_barrier(0x008, 2 * NDS, 0); }
            const bool need_mask = (j == 1) || ((VAR == 1 || VAR == 3) && cj == cq);
            const int pk0 = 64 * j + 4 * hi;
            unsigned pw[16];
            bool skip_pv = false;
            if (VAR != 3) {
                if (VAR == 1) {
                    const LAS float* Ft = (const LAS float*)(lds + AT_F0 + buf * AT_FBUF);
#pragma unroll
                    for (int g = 0; g < 4; ++g) { const f32x4 f0 = *(const LAS f32x4*)(Ft + 8 * g + 4 * hi), f1 = *(const LAS f32x4*)(Ft + 32 + 8 * g + 4 * hi);
#pragma unroll
                        for (int k = 0; k < 4; ++k) { p0[4 * g + k] += f0[k]; p1[4 * g + k] += f1[k]; } }
                } else if (VAR == 0) {
                    const float dq = (float)(pq - pk0); const float cap = (j == 1) ? 128.0f : 1e30f;
#pragma unroll
                    for (int r = 0; r < 16; ++r) { const float c0 = (float)(8 * (r >> 2) + (r & 3));
                        p0[r] = fmaf(-slope2, fminf(fabsf(dq - c0), cap), p0[r]); p1[r] = fmaf(-slope2, fminf(fabsf(dq - (c0 + 32.0f)), cap), p1[r]); }
                }
                if (need_mask) {
#pragma unroll
                    for (int r = 0; r < 16; ++r) { const int pk = pk0 + 8 * (r >> 2) + (r & 3);
                        bool v0 = (pk >= PADF), v1 = (pk + 32 >= PADF); if (VAR == 1) { v0 = v0 && (pk <= pq); v1 = v1 && (pk + 32 <= pq); }
                        if (!v0) p0[r] = -1e30f; if (!v1) p1[r] = -1e30f; }
                }
                float mxa = fmaxf(fmaxf(p0[0], p0[1]), p1[0]), mxb = fmaxf(fmaxf(p0[2], p0[3]), p1[1]); mxa = fmaxf(fmaxf(mxa, p1[2]), p1[3]);
#pragma unroll
                for (int r = 4; r < 16; r += 4) { mxa = fmaxf(fmaxf(mxa, p0[r]), p0[r + 1]); mxb = fmaxf(fmaxf(mxb, p0[r + 2]), p0[r + 3]); mxa = fmaxf(fmaxf(mxa, p1[r]), p1[r + 1]); mxb = fmaxf(fmaxf(mxb, p1[r + 2]), p1[r + 3]); }
                const float rm = swap_max(fmaxf(mxa, mxb));
                const bool tile_zero = __all(rm < -200.0f);
                if (!tile_zero) {
                if (__any(rm > ATT_THR)) {
                    const float dl = fmaxf(rm, 0.f); mhat += dl;
#pragma unroll
                    for (int r = 0; r < 16; ++r) { p0[r] -= dl; p1[r] -= dl; }
                    const float f = __builtin_amdgcn_exp2f(-dl); l_run *= f;
#pragma unroll
                    for (int r = 0; r < 16; ++r) { o0[r] *= f; o1[r] *= f; }
                }
                float lsa = 0.f, lsb = 0.f;
#pragma unroll
                for (int r = 0; r < 16; ++r) { p0[r] = __builtin_amdgcn_exp2f(p0[r]); p1[r] = __builtin_amdgcn_exp2f(p1[r]); lsa += p0[r]; lsb += p1[r]; }
                l_run += lsa + lsb;
                }
                skip_pv = tile_zero;
            } else {
                float e0[4], e1[4];
#pragma unroll
                for (int r = 0; r < 16; ++r) {
                    float k0 = __builtin_amdgcn_rcpf(1.0f + __builtin_amdgcn_exp2f(p0[r])), k1 = __builtin_amdgcn_rcpf(1.0f + __builtin_amdgcn_exp2f(p1[r]));
                    if (need_mask) { const int pk = pk0 + 8 * (r >> 2) + (r & 3);
                        if (!((pk >= PADF) && (pk < pq))) k0 = 1.0f; if (!((pk + 32 >= PADF) && (pk + 32 < pq))) k1 = 1.0f; }
                    p0[r] = k0; p1[r] = k1;
                    if ((r & 3) == 0) { e0[r >> 2] = k0; e1[r >> 2] = k1; } else { e0[r >> 2] *= k0; e1[r >> 2] *= k1; }
                }
                float E[8], Od[8];
#pragma unroll
                for (int g = 0; g < 4; ++g) { swap_both(e0[g], E[g], Od[g]); swap_both(e1[g], E[4 + g], Od[4 + g]); }
                float run = R_run, sufE[8], sufO[8];
#pragma unroll
                for (int g = 7; g >= 0; --g) { sufO[g] = run; run *= Od[g]; sufE[g] = run; run *= E[g]; }
                R_run = run; wave_dead = __all(run == 0.f);
#pragma unroll
                for (int g = 0; g < 4; ++g) {
                    float b0 = hi ? sufO[g] : sufE[g], b1 = hi ? sufO[4 + g] : sufE[4 + g];
#pragma unroll
                    for (int k = 3; k >= 0; --k) { const float t0 = p0[4 * g + k] * b0, t1 = p1[4 * g + k] * b1; p0[4 * g + k] = b0 - t0; p1[4 * g + k] = b1 - t1; b0 = t0; b1 = t1; }
                }
            }
            if (!skip_pv) {
#pragma unroll
            for (int r = 0; r < 8; ++r) { pw[r] = cvtpk(p0[2 * r], p0[2 * r + 1]); pw[8 + r] = cvtpk(p1[2 * r], p1[2 * r + 1]); }
            { s16x4 vlo[8], vhi[8];
#pragma unroll
              for (int s = 0; s < 4; ++s)
#pragma unroll
                for (int dh = 0; dh < 2; ++dh) { const LAS unsigned char* vp = Vt + vbase + (2 * s) * 1024 + dh * 512;
                    vlo[2 * s + dh] = __builtin_bit_cast(s16x4, __builtin_amdgcn_ds_read_tr16_b64_v4i16((LAS s16x4*)vp));
                    vhi[2 * s + dh] = __builtin_bit_cast(s16x4, __builtin_amdgcn_ds_read_tr16_b64_v4i16((LAS s16x4*)(vp + 1024))); }
              __builtin_amdgcn_sched_group_barrier(0x100, 16, 0);
#pragma unroll
              for (int s = 0; s < 4; ++s) {
                const u32x4 pf4 = {pw[4 * s], pw[4 * s + 1], pw[4 * s + 2], pw[4 * s + 3]}; const bf16x8 pf = __builtin_bit_cast(bf16x8, pf4);
#pragma unroll
                for (int dh = 0; dh < 2; ++dh) { const s16x4 lo = vlo[2 * s + dh], hh = vhi[2 * s + dh];
                    const bf16x8 vf = {lo[0], lo[1], lo[2], lo[3], hh[0], hh[1], hh[2], hh[3]};
                    if (dh == 0) o0 = __builtin_amdgcn_mfma_f32_32x32x16_bf16(vf, pf, o0, 0, 0, 0); else o1 = __builtin_amdgcn_mfma_f32_32x32x16_bf16(vf, pf, o1, 0, 0, 0);
                }
              }
              __builtin_amdgcn_sched_group_barrier(0x008, 8, 0); }
            }
        }
    };
    for (int i0 = 0; i0 < ntile; i0 += 2) {
        const int base = i0 & 2;
        if (i0 + 2 < ntile) AT_LOAD(a, TILE_OF(i0 + 2));
        if (i0 + 3 < ntile) AT_LOAD(b, TILE_OF(i0 + 3));
        compute_tile(TILE_OF(i0), base);
        if (i0 + 1 < ntile) compute_tile(TILE_OF(i0 + 1), base + 1);
        if (i0 + 2 < ntile) AT_WRITE(a, base ^ 2);
        if (i0 + 3 < ntile) AT_WRITE(b, (base ^ 2) + 1);
        if (VAR == 3) {
            volatile LAS int* fl = (volatile LAS int*)(lds + AT_END) + 8 * ((i0 >> 1) & 1);
            if (lane == 0) fl[wid] = (!wave_on || wave_dead) ? 1 : 0;
            __syncthreads();
            const u32x4 fa = *(const LAS u32x4*)(lds + AT_END + 32 * ((i0 >> 1) & 1)), fb = *(const LAS u32x4*)(lds + AT_END + 32 * ((i0 >> 1) & 1) + 16);
            if (fa.x & fa.y & fa.z & fa.w & fb.x & fb.y & fb.z & fb.w) break; }
        else __syncthreads();
    }
    const float l_tot = swap_sum(l_run);
    if (wave_on) {
        const float inv = (VAR != 3) ? 1.0f / l_tot : 1.0f;
        LAS unsigned char* st = lds + wid * 4608;
#pragma unroll
        for (int g = 0; g < 4; ++g) {
            const u32x2 w0 = {cvtpk(o0[4 * g] * inv, o0[4 * g + 1] * inv), cvtpk(o0[4 * g + 2] * inv, o0[4 * g + 3] * inv)};
            const u32x2 w1 = {cvtpk(o1[4 * g] * inv, o1[4 * g + 1] * inv), cvtpk(o1[4 * g + 2] * inv, o1[4 * g + 3] * inv)};
            *(LAS u32x2*)(st + rr * 144 + 8 * hi + 16 * g) = w0; *(LAS u32x2*)(st + rr * 144 + 64 + 8 * hi + 16 * g) = w1;
        }
        const int sr = lane >> 3, sc = lane & 7;
        bf16_t* ybase = T.y + (rowb + pq0 + sr) * DM + 256 * VAR + 64 * h + 8 * sc;
#pragma unroll
        for (int j = 0; j < 4; ++j) { const u32x4 v = *(const LAS u32x4*)(st + (8 * j + sr) * 144 + 16 * sc); if (pq0 + 8 * j + sr >= PADF) *(u32x4*)(ybase + (size_t)(8 * j) * DM) = v; }
    }
    __syncthreads();
#undef TILE_OF
#undef AT_LOAD
#undef AT_WRITE
}

__device__ __forceinline__ void st4bf(bf16_t* p, float a, float b, float c, float d) { u32x2 w = {cvtpk(a, b), cvtpk(c, d)}; *(u32x2*)p = w; }
__device__ __forceinline__ float sumsq8(bf16x8 v) { float s = 0.f;
#pragma unroll
    for (int i = 0; i < 8; ++i) { const float f = bf2f((bf16_t)v[i]); s += f * f; } return s; }

__device__ __forceinline__ void mla_task(int bi, int qa, int qb, int ka, int kb, const bf16_t* proj, const bf16_t* Wuq, const bf16_t* Wukv, const f32x2* rope, bf16_t* qm, bf16_t* km, bf16_t* vm, int lane, LAS unsigned char* st) {
    const int rr = lane & 31, hi = lane >> 5;
    const int m = bi < NB * 128 ? (bi >> 7) * LSEQ + 128 + 32 * (bi & 127) + rr : (2 * (bi - NB * 128) + (rr >> 4)) * LSEQ + PADF + (rr & 15);
    const int pos = m % LSEQ - PADF;
    const int sr = lane >> 2, sc = lane & 3;
    const int M0 = (bi < NB * 128 ? (bi >> 7) * LSEQ + 128 + 32 * (bi & 127) : (2 * (bi - NB * 128)) * LSEQ + PADF) + sr, M1 = (bi < NB * 128 ? M0 + 16 : M0 + LSEQ);
#define MLA_STORE(dst_, ld_, col_, a_) do { \
        _Pragma("unroll") for (int g = 0; g < 4; ++g) { const u32x2 w_ = {cvtpk(a_[4 * g], a_[4 * g + 1]), cvtpk(a_[4 * g + 2], a_[4 * g + 3])}; *(LAS u32x2*)(st + rr * 80 + 8 * hi + 16 * g) = w_; } \
        const u32x4 v0_ = *(LAS u32x4*)(st + sr * 80 + 16 * sc), v1_ = *(LAS u32x4*)(st + (sr + 16) * 80 + 16 * sc); \
        *(u32x4*)((dst_) + (size_t)M0 * (ld_) + (col_) + 8 * sc) = v0_; *(u32x4*)((dst_) + (size_t)M1 * (ld_) + (col_) + 8 * sc) = v1_; } while (0)
    const bf16_t* prow = proj + (size_t)m * NPROJ;
    const f32x2* rt = rope + (size_t)pos * 16;
    if (qa < qb) {
        bf16x8 cq[16]; float ss = 0.f;
#pragma unroll
        for (int ks = 0; ks < 16; ++ks) { cq[ks] = *(const bf16x8*)(prow + C_CQ + 16 * ks + 8 * hi); ss += sumsq8(cq[ks]); }
        ss = swap_sum(ss); const float rs = __builtin_amdgcn_rsqf(ss * (1.0f / 256.0f) + EPS);
        bf16x8 wa[8], wb[8]; f32x16 acc = {};
#define MLA_LOADQ(dst, nb_, kh_) do { const bf16_t* wf_ = Wuq + (size_t)(nb_) * 8192 + (kh_) * 4096 + lane * 8; _Pragma("unroll") for (int ks = 0; ks < 8; ++ks) dst[ks] = *(const bf16x8*)(wf_ + ks * 512); } while (0)
#define MLA_DOQ(src, nb_, kh_) do { \
            _Pragma("unroll") for (int ks = 0; ks < 8; ++ks) acc = __builtin_amdgcn_mfma_f32_32x32x16_bf16(src[ks], cq[8 * (kh_) + ks], acc, 0, 0, 0); \
            if (kh_) { _Pragma("unroll") for (int r = 0; r < 16; ++r) acc[r] *= rs; \
              const int head = nb_ / 3, part = nb_ - 3 * head; \
              if (part == 2) { _Pragma("unroll") for (int r = 0; r < 8; ++r) { const f32x2 cs = rt[crow(r, hi)]; const float x1 = acc[r], x2 = acc[r + 8]; acc[r] = x1 * cs.x - x2 * cs.y; acc[r + 8] = x1 * cs.y + x2 * cs.x; } } \
              MLA_STORE(qm, 384, 96 * head + 32 * part, acc); \
              acc = (f32x16){}; } } while (0)
        MLA_LOADQ(wa, qa, 0);
#pragma unroll 1
        for (int nb = qa; nb < qb; ++nb) { MLA_LOADQ(wb, nb, 1); MLA_DOQ(wa, nb, 0); if (nb + 1 < qb) MLA_LOADQ(wa, nb + 1, 0); MLA_DOQ(wb, nb, 1); }
#undef MLA_LOADQ
#undef MLA_DOQ
    }
    if (ka < kb) {
        bf16x8 ck[8]; float ss = 0.f;
#pragma unroll
        for (int ks = 0; ks < 8; ++ks) { ck[ks] = *(const bf16x8*)(prow + C_CKV + 16 * ks + 8 * hi); ss += sumsq8(ck[ks]); }
        ss = swap_sum(ss); const float rs = __builtin_amdgcn_rsqf(ss * (1.0f / 128.0f) + EPS);
        bf16x8 wa[8], wb[8];
#define MLA_LOADK(dst, nb_) do { const bf16_t* wf_ = Wukv + (size_t)(nb_) * 4096 + lane * 8; _Pragma("unroll") for (int ks = 0; ks < 8; ++ks) dst[ks] = *(const bf16x8*)(wf_ + ks * 512); } while (0)
#define MLA_DOK(src, nb_) do { f32x16 acc = {}; _Pragma("unroll") for (int ks = 0; ks < 8; ++ks) acc = __builtin_amdgcn_mfma_f32_32x32x16_bf16(src[ks], ck[ks], acc, 0, 0, 0); \
            const int head = (nb_) >> 2, part = (nb_) & 3; \
            _Pragma("unroll") for (int r = 0; r < 16; ++r) acc[r] *= rs; \
            if (part < 2) MLA_STORE(km, 384, 96 * head + 32 * part, acc); else MLA_STORE(vm, 256, 64 * head + 32 * (part - 2), acc); } while (0)
        MLA_LOADK(wa, 2 * ka);
#pragma unroll 1
        for (int kp = ka; kp < kb; ++kp) { const int nb = 2 * kp; MLA_LOADK(wb, nb + 1); MLA_DOK(wa, nb); if (kp + 1 < kb) MLA_LOADK(wa, nb + 2); MLA_DOK(wb, nb + 1); }
#undef MLA_LOADK
#undef MLA_DOK
        if (kb == 8) {
            const bf16x8 x1 = *(const bf16x8*)(prow + C_CKR + 8 * hi), x2 = *(const bf16x8*)(prow + C_CKR + 16 + 8 * hi);
            float o1[8], o2[8];
#pragma unroll
            for (int t = 0; t < 8; ++t) { const f32x2 cs = rt[8 * hi + t]; const float a = bf2f((bf16_t)x1[t]), b = bf2f((bf16_t)x2[t]); o1[t] = a * cs.x - b * cs.y; o2[t] = a * cs.y + b * cs.x; }
            const u32x4 w1 = {cvtpk(o1[0], o1[1]), cvtpk(o1[2], o1[3]), cvtpk(o1[4], o1[5]), cvtpk(o1[6], o1[7])}, w2 = {cvtpk(o2[0], o2[1]), cvtpk(o2[2], o2[3]), cvtpk(o2[4], o2[5]), cvtpk(o2[6], o2[7])};
#pragma unroll
            for (int hd = 0; hd < 4; ++hd) { bf16_t* o = km + (size_t)m * 384 + 96 * hd + 64 + 8 * hi; *(u32x4*)o = w1; *(u32x4*)(o + 16) = w2; }
        }
    }
#undef MLA_STORE
}


template <bool RESID>
__device__ __forceinline__ void meta_side_task(int t, int nN32, const bf16_t* A, const bf16_t* Bt, bf16_t* outb, int ldo, const float* base_meta, int base_bstride, float* hmeta, LAS unsigned char* lds, int lane, int wave) {
    const int blk = t / nN32, nb = t - blk * nN32, rr = lane & 31, hi = lane >> 5;
    const int b = 2 * blk + (rr >> 4), i = rr & 15; const size_t m = (size_t)b * LSEQ + PADF + i;
    const bf16_t* arow = A + (RESID ? m : (size_t)(b * 16 + i)) * DM + 8 * hi + 128 * wave; const bf16_t* wrow = Bt + (size_t)(32 * nb + rr) * DM + 8 * hi + 128 * wave;
    bf16x8 wf[8], af[8];
#pragma unroll
    for (int ks = 0; ks < 8; ++ks) { wf[ks] = *(const bf16x8*)(wrow + 16 * ks); af[ks] = *(const bf16x8*)(arow + 16 * ks); }
    f32x16 acc = {};
#pragma unroll
    for (int ks = 0; ks < 8; ++ks) acc = __builtin_amdgcn_mfma_f32_32x32x16_bf16(wf[ks], af[ks], acc, 0, 0, 0);
    LAS float* part = (LAS float*)lds;
#pragma unroll
    for (int r = 0; r < 16; ++r) part[(wave * 16 + r) * 64 + lane] = acc[r];
    __syncthreads();
#pragma unroll
    for (int q = 0; q < 2; ++q) { const int r = 2 * wave + q; float sum = 0.f;
#pragma unroll
        for (int w = 0; w < 8; ++w) sum += part[(w * 16 + r) * 64 + lane];
        const int n = 32 * nb + crow(r, hi);
        if (!RESID) outb[m * ldo + n] = (bf16_t)(cvtpk(sum * base_meta[NB * SEQ + b * 16 + i], 0.f) & 0xffffu);
        else { const float hv = base_meta[(size_t)(b * base_bstride + i) * DM + n] + sum; hmeta[(size_t)(b * 16 + i) * DM + n] = hv; outb[(size_t)(b * 16 + i) * DM + n] = (bf16_t)(cvtpk(hv, 0.f) & 0xffffu); } }
    __syncthreads();
}

__device__ __forceinline__ void fscan_unit(int b, const bf16_t* proj, const float* bforget, float* negf, LAS unsigned char* lds, int tid) {
    LAS float* part = (LAS float*)lds;
    constexpr int PER = 9;
    float bf[4]; for (int hh = 0; hh < 4; ++hh) bf[hh] = bforget[hh];
    float loc[PER][4]; float s[4] = {0.f, 0.f, 0.f, 0.f};
#pragma unroll
    for (int i = 0; i < PER; ++i) { const int p = tid * PER + i;
        u32x2 w = {0u, 0u}; if (p < LSEQ) w = *(const u32x2*)(proj + ((size_t)b * LSEQ + p) * NPROJ + C_FG);
        const float fg[4] = {bf_lo(w.x), bf_hi(w.x), bf_lo(w.y), bf_hi(w.y)};
#pragma unroll
        for (int hh = 0; hh < 4; ++hh) { const float x = fg[hh] + bf[hh];
            const float ls = fminf(x, 0.f) - __logf(1.0f + __expf(-fabsf(x))); s[hh] += (p >= PADF && p < LSEQ) ? ls : 0.f; loc[i][hh] = s[hh]; } }
    const int ln = tid & 63, wv = tid >> 6; float offs[4];
#pragma unroll
    for (int hh = 0; hh < 4; ++hh) { float inc = s[hh];
#pragma unroll
        for (int d = 1; d < 64; d <<= 1) { const float o = __int_as_float(__builtin_amdgcn_ds_bpermute(4 * (ln - d), __float_as_int(inc))); inc += ln >= d ? o : 0.f; }
        if (ln == 63) part[wv * 4 + hh] = inc;
        offs[hh] = inc - s[hh]; }
    __syncthreads();
#pragma unroll
    for (int hh = 0; hh < 4; ++hh) {
#pragma unroll
        for (int w2 = 0; w2 < 7; ++w2) offs[hh] += w2 < wv ? part[w2 * 4 + hh] : 0.f; }
#pragma unroll
    for (int hh = 0; hh < 4; ++hh) { const float off = offs[hh];
#pragma unroll
        for (int i = 0; i < PER; ++i) { const int p = tid * PER + i; if (p < LSEQ) negf[((size_t)(b * 4 + hh)) * LSEQ + p] = -(off + loc[i][hh]) * LOG2E; } }
    __syncthreads();
}

__device__ __forceinline__ void router_phase(Frame& F, const bf16_t* hb, const bf16_t* Wrt, const float* bgroup, const float* brouter, unsigned* cnt, int* toke, float* tokw, int* tokp, int* elist, float* rsl) {
    const int lane = F.lane, rr = lane & 31, hi = lane >> 5;
    volatile LAS int* hist = F.MISC + 128;
    constexpr int NBLK = HB_ZERO / 32;
    for (int blk0 = 0; blk0 < NBLK; blk0 += F.NGW) {
    const int blk = blk0 + F.wave * F.G + (int)blockIdx.x;
    const bool active = blk < NBLK;
    if (F.tid < 32) hist[F.tid] = 0;
    __syncthreads();
    int e1 = 0, e2 = 0, r1 = 0, r2 = 0; float w1v = 0.f, w2v = 0.f, rs = 0.f; const int hrow = blk * 32 + rr;
    if (active) {
    const bf16_t* xrow = hb + (size_t)hrow * DM + 8 * hi; const bf16_t* w0 = Wrt + lane * 8; const bf16_t* w1 = Wrt + 32768 + (size_t)(rr & 3) * DM + 8 * hi;
    f32x16 a0 = {}, a1 = {}; float ss = 0.f;
#pragma unroll 1
    for (int k8 = 0; k8 < 64; k8 += 8) {
        bf16x8 xb[8], wa[8]; u32x4 wbu[8];
#pragma unroll
        for (int q = 0; q < 8; ++q) { xb[q] = *(const bf16x8*)(xrow + 16 * (k8 + q)); wa[q] = *(const bf16x8*)(w0 + (k8 + q) * 512); wbu[q] = *(const u32x4*)(w1 + 16 * (k8 + q)); }
#pragma unroll
        for (int q = 0; q < 8; ++q) { if (rr >= 4) wbu[q] = (u32x4){0u, 0u, 0u, 0u}; ss += sumsq8(xb[q]);
            a0 = __builtin_amdgcn_mfma_f32_32x32x16_bf16(wa[q], xb[q], a0, 0, 0, 0); a1 = __builtin_amdgcn_mfma_f32_32x32x16_bf16(__builtin_bit_cast(bf16x8, wbu[q]), xb[q], a1, 0, 0, 0); } }
    ss = swap_sum(ss); rs = __builtin_amdgcn_rsqf(ss * (1.0f / DM) + EPS);
    float gl[4];
#pragma unroll
    for (int i = 0; i < 4; ++i) { float lo, hh; swap_both(a1[i], lo, hh); gl[i] = lo * rs + bgroup[i]; }
    int gt = 0; float gmax = gl[0];
#pragma unroll
    for (int i = 1; i < 4; ++i) if (gl[i] > gmax) { gmax = gl[i]; gt = i; }
    float gs = 0.f;
#pragma unroll
    for (int i = 0; i < 4; ++i) gs += __expf(gl[i] - gmax);
    const float gwt = 1.0f / gs;
    float mine[4];
#pragma unroll
    for (int t = 0; t < 4; ++t) mine[t] = (gt == 0) ? a0[t] : (gt == 1) ? a0[4 + t] : (gt == 2) ? a0[8 + t] : a0[12 + t];
    float el[8];
#pragma unroll
    for (int t = 0; t < 4; ++t) { float lo, hh; swap_both(mine[t], lo, hh); el[t] = lo * rs + brouter[8 * gt + t]; el[4 + t] = hh * rs + brouter[8 * gt + 4 + t]; }
    int i1 = 0; float v1 = el[0];
#pragma unroll
    for (int t = 1; t < 8; ++t) if (el[t] > v1) { v1 = el[t]; i1 = t; }
    int i2 = -1; float v2 = -3.0e38f;
#pragma unroll
    for (int t = 0; t < 8; ++t) if (t != i1 && el[t] > v2) { v2 = el[t]; i2 = t; }
    const float ex = __expf(v2 - v1); w1v = gwt / (1.0f + ex); w2v = gwt * ex / (1.0f + ex);
    e1 = 8 * gt + i1; e2 = 8 * gt + i2;
    if (hi == 0) { r1 = __hip_atomic_fetch_add((LAS int*)&hist[e1], 1, __ATOMIC_RELAXED, __HIP_MEMORY_SCOPE_WORKGROUP); r2 = __hip_atomic_fetch_add((LAS int*)&hist[e2], 1, __ATOMIC_RELAXED, __HIP_MEMORY_SCOPE_WORKGROUP); }
    }
    __syncthreads();
    if (F.tid < 32) { const int c = hist[F.tid]; hist[32 + F.tid] = c ? (int)atomicAdd(cnt + F.tid, (unsigned)c) : 0; }
    __syncthreads();
    if (active && hi == 0) { const int p1 = hist[32 + e1] + r1, p2 = hist[32 + e2] + r2;
        int m; if (hrow < HB_META) { const int b = hrow >> 12, t = hrow & (SEQ - 1); m = b * LSEQ + 128 + t; } else { const int q = hrow - HB_META; m = (q >> 4) * LSEQ + PADF + (q & 15); }
        elist[(size_t)e1 * MROWS + p1] = hrow; elist[(size_t)e2 * MROWS + p2] = hrow; rsl[(size_t)e1 * MROWS + p1] = rs; rsl[(size_t)e2 * MROWS + p2] = rs;
        toke[2 * m] = e1; toke[2 * m + 1] = e2; tokw[2 * m] = w1v; tokw[2 * m + 1] = w2v; tokp[2 * m] = p1; tokp[2 * m + 1] = p2; }
    __syncthreads();
    }
}

__device__ __forceinline__ void expert_tiles_to_lds(Frame& F, const unsigned* cnt) {
    if (F.tid < 64) { const int lane = F.tid; const int c = (lane < NEXP) ? (int)cnt[lane] : 0; const int nfull = c >> 8, rem = c & 255; int incl = nfull;
#pragma unroll
        for (int o = 1; o < 32; o <<= 1) { const int v = shfl_up_l(incl, o, lane); if (lane >= o) incl += v; }
        const int nf = __builtin_amdgcn_ds_bpermute(4 * (NEXP - 1), incl);
        int rank = 0, np = 0;
#pragma unroll
        for (int k = 0; k < NEXP; ++k) { const int rk = __builtin_amdgcn_ds_bpermute(4 * k, rem); rank += (rk > rem || (rk == rem && k < lane)) ? 1 : 0; np += rk > 0 ? 1 : 0; }
        if (lane < NEXP) { F.MISC[lane] = incl - nfull; F.MISC[64 + lane] = c; F.MISC[96 + lane] = nf + rank; if (rem > 0) F.MISC[128 + rank] = lane; }
        if (lane == NEXP - 1) { F.MISC[NEXP] = nf; F.MISC[NEXP + 1] = nf + np; } }
    __syncthreads();
}

#define XB_TMO      128
#define XB_XCNT(j)  (256  + 64 * (j))
#define XB_XSUB(j)  (1280 + 64 * (j))
#define XB_XGEN(j)  (2304 + 64 * (j))
#define XB_TOP      3328
#define XB_TOPGEN   3392
#define XCD_BAR_WORDS 3456
#define XB_SPIN_CAP (1u << 20)
__device__ __forceinline__ unsigned xb_ld(unsigned* p)              { return __hip_atomic_load(p, __ATOMIC_RELAXED, __HIP_MEMORY_SCOPE_AGENT); }
__device__ __forceinline__ unsigned xb_add(unsigned* p, unsigned v) { return __hip_atomic_fetch_add(p, v, __ATOMIC_RELAXED, __HIP_MEMORY_SCOPE_AGENT); }
__device__ __forceinline__ unsigned xb_xcc_id() { return (unsigned)__builtin_amdgcn_s_getreg((3 << 11) | 20) & 0xFu; }
#define XB_SPIN(cond, bar) do { unsigned _sp = 0; while (cond) { __builtin_amdgcn_s_sleep(1); \
    if ((++_sp & 255u) == 0u) { if (xb_ld(&(bar)[XB_TMO])) break; if (_sp > XB_SPIN_CAP) { atomicAdd(&(bar)[XB_TMO], 1u); break; } } } } while (0)
struct XcdBarrier { unsigned* bar; unsigned x; volatile LAS unsigned* st; };
__device__ __forceinline__ XcdBarrier xcd_barrier_post(unsigned* bar, volatile LAS unsigned* st) {
    XcdBarrier b; b.bar = bar; b.x = xb_xcc_id(); b.st = st;
    if (threadIdx.x == 0) (void)xb_add(&bar[XB_XCNT(b.x)], 1u);
    return b;
}
__device__ __forceinline__ void xcd_barrier_complete(unsigned* bar, unsigned x, unsigned& nloc, unsigned& nx) {
    const unsigned G = gridDim.x * gridDim.y * gridDim.z;
    unsigned sum, cnt, mine, sp = 0u;
    for (;;) {
        sum = 0u; cnt = 0u; mine = 0u;
#pragma unroll
        for (unsigned j = 0; j < 16; ++j) { const unsigned c = xb_ld(&bar[XB_XCNT(j)]); sum += c; cnt += (c > 0u) ? 1u : 0u; mine = (j == x) ? c : mine; }
        if (sum == G) break;
        __builtin_amdgcn_s_sleep(1);
        if ((++sp & 255u) == 0u) { if (xb_ld(&bar[XB_TMO])) break; if (sp > XB_SPIN_CAP) { atomicAdd(&bar[XB_TMO], 1u); break; } }
    }
    nloc = mine > 0u ? mine : 1u; nx = cnt > 0u ? cnt : 1u;
}
__device__ __forceinline__ void xcd_barrier(const XcdBarrier& b) {
    asm volatile("s_waitcnt vmcnt(0)" ::: "memory");
    __syncthreads();
    if (threadIdx.x == 0) {
        unsigned* bar = b.bar;
        __builtin_amdgcn_s_waitcnt(0);
        unsigned nloc = b.st[0], nx = b.st[1];
        if (nloc == 0u) { xcd_barrier_complete(bar, b.x, nloc, nx); b.st[0] = nloc; b.st[1] = nx; }
        const unsigned old = xb_add(&bar[XB_XSUB(b.x)], 1u);
        const unsigned gen = old / nloc;
        if (old + 1u == (gen + 1u) * nloc) {
            __builtin_amdgcn_fence(__ATOMIC_RELEASE, "agent");
            asm volatile("s_waitcnt vmcnt(0)" ::: "memory");
            const unsigned og = xb_add(&bar[XB_TOP], 1u);
            const unsigned tg = og / nx;
            if (og + 1u == (tg + 1u) * nx) xb_add(&bar[XB_TOPGEN], 1u);
            else XB_SPIN(xb_ld(&bar[XB_TOPGEN]) == tg, bar);
            __builtin_amdgcn_fence(__ATOMIC_ACQUIRE, "agent");
            xb_add(&bar[XB_XGEN(b.x)], 1u);
            asm volatile("s_waitcnt vmcnt(0)" ::: "memory");
        } else {
            XB_SPIN(xb_ld(&bar[XB_XGEN(b.x)]) == gen, bar);
            __builtin_amdgcn_fence(__ATOMIC_ACQUIRE, "agent");
            asm volatile("s_waitcnt vmcnt(0)" ::: "memory");
        }
    }
    __syncthreads();
}

constexpr int N_PHASES = 20;
typedef const __attribute__((address_space(4))) Args* KArgs;
__device__ __forceinline__ KArgs kargs() { auto p = __builtin_amdgcn_kernarg_segment_ptr(); asm volatile("" : "+s"(p)); return (KArgs)p; }
#ifndef PH_MASK
#define PH_MASK 0xFFFFFu
#endif

__global__ void __launch_bounds__(NTHREADS, 2) hymba_fwd(Args args_unused) {
    extern __shared__ __attribute__((aligned(16))) unsigned char lds_raw[];
    Frame F;
    F.lds = (LAS unsigned char*)lds_raw; F.MISC = (volatile LAS int*)(F.lds + MISC_OFF);
    F.tid = threadIdx.x; F.lane = F.tid & 63; F.wave = __builtin_amdgcn_readfirstlane(F.tid >> 6);
    F.G = gridDim.x; F.gw = blockIdx.x * NWAVES + F.wave; F.NGW = F.G * NWAVES;
    int lo, hi_ph; { KArgs A = kargs(); lo = A->ph_lo; hi_ph = A->ph_hi; }
    for (int u = F.tid; u < 64; u += NTHREADS) F.MISC[u] = 0;
    __syncthreads();
#if MK_N_LAUNCHES == 1
    XcdBarrier bar; { KArgs A = kargs(); bar = xcd_barrier_post((unsigned*)(A->ws + WS_CTL) + CW_BAR, (volatile LAS unsigned*)(F.MISC + 48)); }
#endif
#define IN(k) ((((PH_MASK) >> ((k) > 9 ? (k) - 9 : (k))) & 1u) && lo <= (k) && (k) < hi_ph)
#if MK_N_LAUNCHES == 1
#ifndef USE_CG_ALL
#define USE_CG_ALL 0
#endif
#define SEAM_CG() do { if (kargs()->ws == nullptr) cg::this_grid().sync(); xcd_barrier(bar); } while (0)
#define SEAM() do { if (USE_CG_ALL) cg::this_grid().sync(); else xcd_barrier(bar); } while (0)
#else
#define SEAM() do { } while (0)
#define SEAM_CG() do { } while (0)
#endif
#define WSP(T, off) ((T)(ws + (off)))
#ifndef DUP_MASK
#define DUP_MASK 0u
#endif
#define NREP(k, l0) ((((DUP_MASK) >> (k)) & 1u) && (l0) ? 2 : 1)
#define REP_SEAM() do { if (rep > 0) SEAM(); } while (0)
#define PHASE_TID() do { int t_ = threadIdx.x; asm volatile("" : "+v"(t_)); F.tid = t_; F.lane = t_ & 63; F.wave = __builtin_amdgcn_readfirstlane(t_ >> 6); F.gw = blockIdx.x * NWAVES + F.wave; } while (0)

    if (IN(0)) for (int rep = 0; rep < NREP(0, true); ++rep) {
        KArgs A = kargs(); unsigned char* ws = A->ws; PHASE_TID(); REP_SEAM();
        LAS float* scr = (LAS float*)(F.lds + F.wave * 16384);
        constexpr int per_layer = (1024 / 64) * (NPROJ / 32) + (1024 / 64) * (1024 / 32);
        for (int it0 = F.gw; it0 < 2 * per_layer; it0 += F.NGW) {
            const int l = it0 / per_layer, it = it0 - l * per_layer;
            int base = 0; bool done = false;
            unsigned char* wl = ws + WS_W + (size_t)l * W_LAYER;
            transpose_matrix(F, base, it, A->in[3] + (size_t)l * 1024 * 2468, 1024, 2468, NPROJ, A->in[2] + l * DM, (bf16_t*)(wl + W_IN),
                [](int nb, int& sc, int& nv, int& dr) { const int n0 = 32 * nb; dr = n0; if (n0 < 1280) { sc = n0; nv = 32; } else if (n0 < 2464) { sc = n0 + 4; nv = 32; } else if (n0 == 2464) { sc = 1280; nv = 4; } else { sc = 0; nv = 0; } }, scr, done);
            transpose_matrix(F, base, it, A->in[10] + (size_t)l * 1024 * 1024, 1024, 1024, 1024, nullptr, (bf16_t*)(wl + W_OUT),
                [](int nb, int& sc, int& nv, int& dr) { sc = 32 * nb; nv = 32; dr = 32 * nb; }, scr, done);
        }
        for (int i = blockIdx.x * NTHREADS + F.tid; i < 2 * (98304 + 65536 + 32768 + 4096); i += F.G * NTHREADS) {
            const int l = i / (98304 + 65536 + 32768 + 4096); int r = i - l * (98304 + 65536 + 32768 + 4096); unsigned char* wl = ws + WS_W + (size_t)l * W_LAYER;
            if (r < 98304) { const int nb = r >> 13, ks = (r >> 9) & 15, ln = (r >> 3) & 63, j = r & 7, n = 32 * nb + (ln & 31), k = 16 * ks + 8 * (ln >> 5) + j;
                const float v = A->in[8][(size_t)l * 256 * 384 + (size_t)k * 384 + n] * A->in[6][l * 256 + k]; ((bf16_t*)(wl + W_UQ))[r] = (bf16_t)(cvtpk(v, 0.f) & 0xffffu); continue; }
            r -= 98304;
            if (r < 65536) { const int nb = r >> 12, ks = (r >> 9) & 7, ln = (r >> 3) & 63, j = r & 7, n = 32 * nb + (ln & 31), k = 16 * ks + 8 * (ln >> 5) + j;
                const float v = A->in[9][(size_t)l * 128 * 512 + (size_t)k * 512 + n] * A->in[7][l * 128 + k]; ((bf16_t*)(wl + W_UKV))[r] = (bf16_t)(cvtpk(v, 0.f) & 0xffffu); continue; }
            r -= 65536;
            if (r < 32768) { const int ks = r >> 9, ln = (r >> 3) & 63, j = r & 7, n = ln & 31, k = 16 * ks + 8 * (ln >> 5) + j;
                const float v = A->in[14][(size_t)l * 1024 * 32 + (size_t)k * 32 + n] * A->in[11][l * DM + k]; ((bf16_t*)(wl + W_RT))[r] = (bf16_t)(cvtpk(v, 0.f) & 0xffffu); continue; }
            r -= 32768;
            { const int n = r >> 10, k = r & 1023; const float v = A->in[12][(size_t)l * 1024 * 4 + (size_t)k * 4 + n] * A->in[11][l * DM + k]; ((bf16_t*)(wl + W_RT))[32768 + r] = (bf16_t)(cvtpk(v, 0.f) & 0xffffu); }
        }
        if (blockIdx.x == 0 && F.tid < 256) ((u32x2*)(WSP(bf16_t*, WS_HB) + (size_t)HB_ZERO * DM))[F.tid] = (u32x2){0u, 0u};
        f32x2* ROPE = WSP(f32x2*, WS_SMALL + SM_ROPE);
        for (int i = blockIdx.x * NTHREADS + F.tid; i < 4112 * 16; i += F.G * NTHREADS) { const int pos = i >> 4, f = i & 15;
            const float ang = (float)pos * INV_FREQ[f]; float rev = ang * 0.15915494309189535f; rev -= floorf(rev);
            ROPE[i] = (f32x2){__builtin_amdgcn_cosf(rev), __builtin_amdgcn_sinf(rev)}; }
        __syncthreads();
    }

    for (int layer = 0; layer < 2; ++layer) {
        const int P = 1 + 9 * layer;
        if (IN(P + 0)) for (int rep = 0; rep < NREP(1, layer == 0); ++rep) {
            KArgs A = kargs(); unsigned char* ws = A->ws; PHASE_TID(); REP_SEAM();
            if (layer > 0) expert_tiles_to_lds(F, WSP(const unsigned*, WS_CTL) + CW_CNT + 64 * (layer - 1));
            const NormCtx C{A->in[0], A->in[1], A->out, WSP(float*, WS_SMALL + SM_HMETA), WSP(bf16_t*, WS_HB), A->in[2] + layer * DM, WSP(float*, WS_SMALL + SM_RSA), WSP(const bf16_t*, WS_BIG + BIG_XS),
                            WSP(const int*, WS_SMALL + SM_TOKE), WSP(const int*, WS_SMALL + SM_TOKP), WSP(const float*, WS_SMALL + SM_TOKW), F.MISC};
            if (layer == 0) { for (int m0 = 8 * (F.wave * F.G + (int)blockIdx.x); m0 < MROWS; m0 += 8 * F.NGW) norm_rows<0, 8>(C, m0, MROWS, F.lane); }
            else { for (int m0 = 4 * (F.wave * F.G + (int)blockIdx.x); m0 < MROWS; m0 += 4 * F.NGW) norm_rows<1, 4>(C, m0, MROWS, F.lane);
            }
        }
        if (IN(P + 0) && IN(P + 1)) { if (layer == 0) SEAM_CG(); else SEAM(); }
#ifdef EXTRA_BARRIERS
        for (int xb_ = 0; xb_ < EXTRA_BARRIERS; ++xb_) SEAM();
#endif
        if (IN(P + 1)) for (int rep = 0; rep < NREP(2, layer == 0); ++rep) {
            KArgs A = kargs(); unsigned char* ws = A->ws; PHASE_TID(); REP_SEAM(); unsigned char* wl = ws + WS_W + (size_t)layer * W_LAYER;
            pg8::DenseOrder S; S.init(ws + WS_HB, wl + W_IN, DM, DM, MROWS, NPROJ, F.G, (int)blockIdx.x, true);
            pg8::EpiProj E{WSP(bf16_t*, WS_BIG + BIG_PROJ), NPROJ, WSP(const float*, WS_SMALL + SM_RSA)};
            pg8::gemm_phase<false>(F.tid, F.lds, pg8::Gemm{DM, DM, DM}, S, E);
            for (int t = (int)blockIdx.x; t < 4 * (NPROJ / 32); t += F.G)
                meta_side_task<false>(t, NPROJ / 32, WSP(const bf16_t*, WS_HB) + (size_t)HB_META * DM, (const bf16_t*)(wl + W_IN), WSP(bf16_t*, WS_BIG + BIG_PROJ), NPROJ, WSP(const float*, WS_SMALL + SM_RSA), 0, nullptr, F.lds, F.lane, F.wave);
            for (int t = (7 - F.wave) * F.G + (int)blockIdx.x; t < NB * PADF; t += F.NGW) { const int b = t / PADF, p = t - b * PADF; u32x4* o = (u32x4*)(WSP(bf16_t*, WS_BIG + BIG_PROJ) + ((size_t)b * LSEQ + p) * NPROJ) + F.lane;
#pragma unroll
                for (int q = 0; q < NPROJ / 512; ++q) o[64 * q] = (u32x4){0u, 0u, 0u, 0u}; }
        }
        if (IN(P + 1) && IN(P + 2)) SEAM();
        if (IN(P + 2)) for (int rep = 0; rep < NREP(3, layer == 0); ++rep) {
            KArgs A = kargs(); unsigned char* ws = A->ws; PHASE_TID(); REP_SEAM(); unsigned char* wl = ws + WS_W + (size_t)layer * W_LAYER;
            const bf16_t* PROJ = WSP(const bf16_t*, WS_BIG + BIG_PROJ);
            bf16_t* KM = WSP(bf16_t*, WS_BIG + BIG_KM); bf16_t* VM = WSP(bf16_t*, WS_BIG + BIG_VM);
            unsigned zz = 0u; asm volatile("" : "+v"(zz));
            for (int i = (int)blockIdx.x * NTHREADS + F.tid; i < NB * PADF * 80; i += F.G * NTHREADS) { const int r = i / 80, c = i - 80 * r; const size_t mrow = (size_t)(r / PADF) * LSEQ + r % PADF;
                if (c < 48) *(u32x4*)(KM + mrow * 384 + 8 * c) = (u32x4){zz, zz, zz, zz}; else *(u32x4*)(VM + mrow * 256 + 8 * (c - 48)) = (u32x4){zz, zz, zz, zz}; }
            const bool fsc = (int)blockIdx.x >= F.G - NB;
            if (fsc) fscan_unit(F.G - 1 - (int)blockIdx.x, PROJ, A->in[4] + layer * 4, WSP(float*, WS_SMALL + SM_NEGF), F.lds, F.tid);
            constexpr int UNITS = (NB * 128 + NB / 2) * 20, FQ = 6;
            const int nwo = F.NGW - NB * NWAVES, rest = UNITS - FQ * NB * NWAVES, base = rest / nwo, extra = rest - base * nwo;
            int u0, u1;
            if (!fsc) { const int i = F.gw; u0 = base * i + min(i, extra); u1 = u0 + base + (i < extra ? 1 : 0); }
            else { const int j = F.gw - nwo; u0 = rest + FQ * j; u1 = u0 + FQ; }
#pragma unroll 1
            while (u0 < u1) { const int bi = u0 / 20, l0 = u0 - 20 * bi, l1 = min(20, l0 + (u1 - u0));
                mla_task(bi, min(l0, 12), min(l1, 12), max(l0, 12) - 12, max(l1, 12) - 12, PROJ, (const bf16_t*)(wl + W_UQ), (const bf16_t*)(wl + W_UKV), WSP(const f32x2*, WS_SMALL + SM_ROPE), WSP(bf16_t*, WS_BIG + BIG_QM), KM, VM, F.lane, F.lds + 8192 + F.wave * 4096);
                u0 += l1 - l0; }
        }
        if (IN(P + 2) && IN(P + 3)) SEAM();
        if (IN(P + 3)) for (int rep = 0; rep < NREP(4, layer == 0); ++rep) {
            KArgs A = kargs(); unsigned char* ws = A->ws; PHASE_TID(); REP_SEAM();
            const AttnArgs T{WSP(const bf16_t*, WS_BIG + BIG_PROJ), WSP(const bf16_t*, WS_BIG + BIG_QM), WSP(const bf16_t*, WS_BIG + BIG_KM), WSP(const bf16_t*, WS_BIG + BIG_VM), WSP(const float*, WS_SMALL + SM_NEGF), A->in[5] + layer * 4, WSP(bf16_t*, WS_XN)};
            unsigned* qhead = WSP(unsigned*, WS_CTL) + CW_ATTQ + 64 * layer + 16 * rep;
            constexpr int NU_ATT = 16 * 96, NU_MAIN = NU_ATT + XW_WG_ITEMS, NU_A = 512, NU_META = 128, NU = NU_MAIN + NU_A + NU_META;
            static_assert(NU_ATT == 6 * XW_WG_ITEMS, "one conversion item after every 6 attention units");
            for (;;) {
                if (F.tid == 0) F.MISC[40] = (int)atomicAdd(qhead, 1u);
                __syncthreads();
                const int idx = F.MISC[40];
                __syncthreads();
                if (idx >= NU) break;
                if (idx < NU_MAIN && idx % 7 == 6) {
                    xw_wg_item(idx / 7, F.wave, F.lane, A->in[16] + (size_t)layer * NEXP * 1024 * 512, A->in[17] + (size_t)layer * NEXP * 1024 * 512, A->in[18] + (size_t)layer * NEXP * 512 * 1024, A->in[11] + layer * DM,
                               (bf16_t*)(ws + WS_WMOE + WM_GU), (bf16_t*)(ws + WS_WMOE + WM_DN), (LAS float*)(F.lds + F.wave * 16384)); }
                else if (idx < NU_MAIN) { const int ai_ = idx - (idx + 1) / 7; const int u = 15 - ai_ / 96, rem = ai_ % 96, var = rem >> 5, bh = rem & 31, b = bh >> 2, h = bh & 3;
                    if (var == 2) attn_unit<3>(F.tid, T, b, h, u, F.lds); else if (var == 1) attn_unit<1>(F.tid, T, b, h, u, F.lds); else attn_unit<2>(F.tid, T, b, h, u, F.lds);
#ifdef ATT_DUP_VAR
                    if (ATT_DUP_VAR == 3 && var == 2) attn_unit<3>(F.tid, T, b, h, u, F.lds); if (ATT_DUP_VAR == 1 && var == 1) attn_unit<1>(F.tid, T, b, h, u, F.lds); if (ATT_DUP_VAR == 2 && var == 0) attn_unit<2>(F.tid, T, b, h, u, F.lds);
#endif
                    }
                else if (idx < NU_MAIN + NU_A) { const int r = idx - NU_MAIN, u = 15 - (r >> 5), bh = r & 31; attn_unit<0>(F.tid, T, bh >> 2, bh & 3, u, F.lds); }
                else { const int r = idx - NU_MAIN - NU_A, var = r >> 5, bh = r & 31, b = bh >> 2, h = bh & 3;
                    if (var == 0) attn_unit<0>(F.tid, T, b, h, -1, F.lds); else if (var == 1) attn_unit<1>(F.tid, T, b, h, -1, F.lds); else if (var == 2) attn_unit<2>(F.tid, T, b, h, -1, F.lds); else attn_unit<3>(F.tid, T, b, h, -1, F.lds); }
            }
        }
        if (IN(P + 3) && IN(P + 4)) SEAM();
        if (IN(P + 4)) for (int rep = 0; rep < NREP(5, layer == 0); ++rep) {
            KArgs A = kargs(); unsigned char* ws = A->ws; PHASE_TID(); REP_SEAM(); unsigned char* wl = ws + WS_W + (size_t)layer * W_LAYER;
            float* out = A->out; float* HMETA = WSP(float*, WS_SMALL + SM_HMETA);
            pg8::DenseOrder S; S.init(ws + WS_XN, wl + W_OUT, DM, DM, MROWS, DM, F.G, (int)blockIdx.x, false);
            pg8::EpiResid E{WSP(bf16_t*, WS_HB)};
            pg8::gemm_phase<false>(F.tid, F.lds, pg8::Gemm{DM, DM, DM}, S, E);
            for (int t = (int)blockIdx.x; t < 4 * (DM / 32); t += F.G)
                meta_side_task<true>(t, DM / 32, WSP(const bf16_t*, WS_XN), (const bf16_t*)(wl + W_OUT), WSP(bf16_t*, WS_HB) + (size_t)HB_META * DM, 0, layer == 0 ? A->in[1] : HMETA, layer == 0 ? 0 : 16, HMETA, F.lds, F.lane, F.wave);
        }
        if (IN(P + 4) && IN(P + 5)) SEAM();
        if (IN(P + 5)) for (int rep = 0; rep < NREP(6, layer == 0); ++rep) {
            KArgs A = kargs(); unsigned char* ws = A->ws; PHASE_TID(); REP_SEAM(); unsigned char* wl = ws + WS_W + (size_t)layer * W_LAYER;
            router_phase(F, WSP(const bf16_t*, WS_HB), (const bf16_t*)(wl + W_RT), A->in[13] + layer * 4, A->in[15] + layer * 32,
                         WSP(unsigned*, WS_CTL) + CW_CNT + 64 * layer + 32 * rep, WSP(int*, WS_SMALL + SM_TOKE), WSP(float*, WS_SMALL + SM_TOKW), WSP(int*, WS_SMALL + SM_TOKP), WSP(int*, WS_SMALL + SM_ELIST), WSP(float*, WS_SMALL + SM_RSL));
        }
        if (IN(P + 5) && IN(P + 7)) SEAM();
        if (IN(P + 7)) {
            KArgs A = kargs(); unsigned char* ws = A->ws; PHASE_TID(); unsigned char* wl = ws + WS_W + (size_t)layer * W_LAYER;
            expert_tiles_to_lds(F, WSP(const unsigned*, WS_CTL) + CW_CNT + 64 * layer);
            pg8::GroupedOrder S{(const char*)(ws + WS_HB), (const char*)(ws + WS_WMOE + WM_GU), DM, DM, (size_t)1024 * 1024 * 2, F.MISC, F.MISC[NEXP + 1], F.G, (int)blockIdx.x,
                                WSP(const int*, WS_SMALL + SM_ELIST), WSP(const unsigned*, WS_CTL) + CW_CNT + 64 * layer, true, 0, nullptr};
            pg8::EpiSwiGLU E{WSP(bf16_t*, WS_BIG + BIG_HID), EHID, WSP(const float*, WS_SMALL + SM_RSL)};
            pg8::gemm_phase<true>(F.tid, F.lds, pg8::Gemm{DM, DM, DM}, S, E);
        }
        if (IN(P + 7) && IN(P + 8)) SEAM();
        if (IN(P + 8)) {
            KArgs A = kargs(); unsigned char* ws = A->ws; PHASE_TID(); unsigned char* wl = ws + WS_W + (size_t)layer * W_LAYER;
            expert_tiles_to_lds(F, WSP(const unsigned*, WS_CTL) + CW_CNT + 64 * layer);
            unsigned* latecnt = WSP(unsigned*, WS_CTL) + CW_LATE + 16 * layer;
            { pg8::GroupedOrder S{(const char*)(ws + WS_HB), (const char*)(ws + WS_WMOE + WM_GU), DM, DM, (size_t)1024 * 1024 * 2, F.MISC, F.MISC[NEXP + 1], F.G, (int)blockIdx.x,
                                  WSP(const int*, WS_SMALL + SM_ELIST), WSP(const unsigned*, WS_CTL) + CW_CNT + 64 * layer, true, 1, nullptr};
              pg8::Unit probe;
              if (S.next(0, probe)) {
                  pg8::EpiSwiGLU E{WSP(bf16_t*, WS_BIG + BIG_HID), EHID, WSP(const float*, WS_SMALL + SM_RSL)};
                  pg8::gemm_phase<true>(F.tid, F.lds, pg8::Gemm{DM, DM, DM}, S, E);
                  asm volatile("s_waitcnt vmcnt(0)" ::: "memory"); __syncthreads();
                  if (F.tid == 0) { __builtin_amdgcn_fence(__ATOMIC_RELEASE, "agent"); asm volatile("s_waitcnt vmcnt(0)" ::: "memory"); __hip_atomic_fetch_add(latecnt, 1u, __ATOMIC_RELAXED, __HIP_MEMORY_SCOPE_AGENT); }
                  __syncthreads(); } }
            { KArgs A2 = kargs(); unsigned char* ws2 = A2->ws; PHASE_TID();
              pg8::GroupedOrder S{(const char*)(ws2 + WS_BIG + BIG_HID), (const char*)(ws2 + WS_WMOE + WM_DN), EHID, EHID, (size_t)1024 * 512 * 2, F.MISC, F.MISC[NEXP + 1], F.G, (int)blockIdx.x, nullptr, nullptr, false, 2, latecnt};
              pg8::EpiBf16 E{(bf16_t*)(ws2 + WS_BIG + BIG_XS), DM};
              pg8::gemm_phase<false>(F.tid, F.lds, pg8::Gemm{EHID, EHID, EHID}, S, E); }
        }
        if (IN(P + 8) && IN(P + 9)) SEAM();
    }
    if (IN(19)) {
        KArgs A = kargs(); unsigned char* ws = A->ws; PHASE_TID();
        expert_tiles_to_lds(F, WSP(const unsigned*, WS_CTL) + CW_CNT + 64);
        const NormCtx C{nullptr, nullptr, A->out, nullptr, WSP(bf16_t*, WS_HB), A->in[19], nullptr, WSP(const bf16_t*, WS_BIG + BIG_XS), WSP(const int*, WS_SMALL + SM_TOKE), WSP(const int*, WS_SMALL + SM_TOKP), WSP(const float*, WS_SMALL + SM_TOKW), F.MISC};
        for (int m0 = 4 * (F.wave * F.G + (int)blockIdx.x); m0 < NB * SEQ; m0 += 4 * F.NGW) norm_rows<2, 4>(C, m0, NB * SEQ, F.lane);
    }
#undef IN
#undef SEAM
#undef SEAM_CG
#undef WSP
}

extern "C" void kernel_launch(void* const* d_in, const int* in_sizes, int n_in, void* d_out, int out_size, void* d_ws, size_t ws_size, hipStream_t stream) {
    static int grid = 0;
    if (grid == 0) {
        if (n_in != 20 || out_size != NB * SEQ * DM || ws_size < WS_END) { fprintf(stderr, "kernel_launch: unexpected shapes (n_in %d, out %d, ws %zu < %zu)\n", n_in, out_size, ws_size, (size_t)WS_END); grid = -1; return; }
        int dev = 0, cus = 0, per_cu = 0;
        hipGetDevice(&dev); hipDeviceGetAttribute(&cus, hipDeviceAttributeMultiprocessorCount, dev);
        if (hipFuncSetAttribute((const void*)hymba_fwd, hipFuncAttributeMaxDynamicSharedMemorySize, LDS_BYTES) != hipSuccess) { fprintf(stderr, "kernel_launch: hipFuncSetAttribute failed\n"); grid = -1; return; }
        if (hipOccupancyMaxActiveBlocksPerMultiprocessor(&per_cu, (const void*)hymba_fwd, NTHREADS, LDS_BYTES) != hipSuccess || per_cu < 1) { fprintf(stderr, "kernel_launch: occupancy query failed (%d)\n", per_cu); per_cu = 1; }
        (void)hipGetLastError();
        grid = cus;
    }
    if (grid < 0) return;
    hipMemsetAsync((char*)d_ws + WS_CTL, 0, CTL_BYTES, stream);
    Args a{};
    for (int i = 0; i < 20; ++i) a.in[i] = (const float*)d_in[i];
    a.out = (float*)d_out; a.ws = (unsigned char*)d_ws;
#if MK_N_LAUNCHES == 1
    a.ph_lo = 0; a.ph_hi = N_PHASES;
    void* kargs[] = {&a};
    hipError_t e = hipLaunchCooperativeKernel((const void*)hymba_fwd, dim3(grid), dim3(NTHREADS), kargs, LDS_BYTES, stream);
    if (e != hipSuccess) fprintf(stderr, "cooperative launch failed: %s (grid %d)\n", hipGetErrorString(e), grid);
#else
    for (int ph = 0; ph < N_PHASES; ++ph) { a.ph_lo = ph; a.ph_hi = ph + 1; hipLaunchKernelGGL(hymba_fwd, dim3(grid), dim3(NTHREADS), LDS_BYTES, stream, a); }
#endif
}
```

```cpp
#include <hip/hip_runtime.h>
#include <hip/hip_cooperative_groups.h>
#include <cstdio>
#include <cstdint>
namespace cg = cooperative_groups;

#ifndef MK_N_LAUNCHES
#define MK_N_LAUNCHES 1
#endif

constexpr int NB = 8, SEQ = 4096, DM = 1024, LSEQ = SEQ + 128, MROWS = NB * LSEQ;
constexpr int PADF = 112;
constexpr int NPROJ = 2560;
constexpr int C_AQ = 0, C_AK = 256, C_AV = 384, C_FQ = 512, C_FK = 768, C_FV = 1024, C_CQ = 1280, C_CKV = 1536, C_CKR = 1664, C_SQ = 1696, C_SK = 1952, C_SV = 2208, C_FG = 2464;
constexpr int NEXP = 32, EHID = 512;
constexpr float EPS = 1e-6f;
constexpr float LOG2E = 1.4426950408889634f;
constexpr int NWAVES = 8, NTHREADS = 512;
constexpr int HB_META = NB * SEQ, HB_ZERO = NB * SEQ + NB * 16, HB_ROWS = HB_ZERO + 1;
constexpr int PMAX_ROWS = 74240;

constexpr size_t MiB = 1u << 20;
constexpr size_t WS_CTL = 0, CTL_BYTES = 1 * MiB;
constexpr size_t W_IN = 0, W_OUT = W_IN + (size_t)NPROJ * DM * 2, W_UQ = W_OUT + (size_t)DM * DM * 2, W_UKV = W_UQ + 384 * 256 * 2, W_RT = W_UKV + 512 * 128 * 2, W_LAYER = W_RT + 64 * 1024 * 2;
constexpr size_t WM_GU = 0, WM_DN = WM_GU + (size_t)NEXP * 1024 * 1024 * 2, WM_END = WM_DN + (size_t)NEXP * 1024 * 512 * 2;
constexpr size_t WS_W = 1 * MiB;
constexpr size_t WS_WMOE = 17 * MiB;
constexpr size_t WS_HB = 114 * MiB;
constexpr size_t WS_XN = 179 * MiB;
constexpr size_t WS_BIG = 246 * MiB;
constexpr size_t BIG_PROJ = 0, BIG_QM = (size_t)MROWS * NPROJ * 2, BIG_KM = BIG_QM + (size_t)MROWS * 384 * 2, BIG_VM = BIG_KM + (size_t)MROWS * 384 * 2, BIG_ATT_END = BIG_VM + (size_t)MROWS * 256 * 2;
constexpr size_t BIG_XS = 0, BIG_HID = (size_t)PMAX_ROWS * 1024 * 2, BIG_MOE_END = BIG_HID + (size_t)PMAX_ROWS * 512 * 2;
constexpr size_t WS_SMALL = 478 * MiB;
constexpr size_t SM_NEGF = 0, SM_ROPE = SM_NEGF + (size_t)NB * 4 * LSEQ * 4, SM_TOKE = SM_ROPE + (size_t)4112 * 16 * 8, SM_TOKW = SM_TOKE + (size_t)MROWS * 8, SM_TOKP = SM_TOKW + (size_t)MROWS * 8,
                 SM_HMETA = SM_TOKP + (size_t)MROWS * 8, SM_ELIST = SM_HMETA + (size_t)NB * 16 * DM * 4, SM_RSL = SM_ELIST + (size_t)NEXP * MROWS * 4, SM_RSA = SM_RSL + (size_t)NEXP * MROWS * 4, SM_END = SM_RSA + (size_t)(NB * SEQ + NB * 16) * 4;
constexpr size_t WS_END = WS_SMALL + 12 * MiB;
static_assert(WS_W + 2 * W_LAYER <= WS_WMOE && WS_WMOE + WM_END <= WS_HB && WS_HB + (size_t)HB_ROWS * DM * 2 <= WS_XN, "weights / residual regions");
static_assert(WS_XN + (size_t)MROWS * DM * 2 <= WS_BIG, "xn region");
static_assert(WS_BIG + BIG_ATT_END <= WS_SMALL && WS_BIG + BIG_MOE_END <= WS_SMALL, "big region");
static_assert(SM_END <= 12 * MiB, "small region");
constexpr int CW_ATTQ = 64;
constexpr int CW_CNT = 256;
constexpr int CW_LATE = 512;
constexpr int CW_BAR = 4096;

constexpr int RING_BYTES = 131072;
constexpr int MISC_OFF = RING_BYTES;
constexpr int LDS_BYTES = 147456;

#define GAS __attribute__((address_space(1)))
#define LAS __attribute__((address_space(3)))
typedef unsigned short bf16_t;
typedef short bf16x8 __attribute__((ext_vector_type(8)));
typedef short s16x4 __attribute__((ext_vector_type(4)));
typedef float f32x4 __attribute__((ext_vector_type(4)));
typedef float f32x2 __attribute__((ext_vector_type(2)));
typedef float f32x16 __attribute__((ext_vector_type(16)));
typedef unsigned u32x4 __attribute__((ext_vector_type(4)));
typedef unsigned u32x2 __attribute__((ext_vector_type(2)));
typedef __bf16 bf16x2_t __attribute__((ext_vector_type(2)));

__device__ __forceinline__ unsigned cvtpk(float lo, float hi) { f32x2 v = {lo, hi}; bf16x2_t b = __builtin_convertvector(v, bf16x2_t); return __builtin_bit_cast(unsigned, b); }
__device__ __forceinline__ float bf_lo(unsigned w) { return __uint_as_float(w << 16); }
__device__ __forceinline__ float bf_hi(unsigned w) { return __uint_as_float(w & 0xffff0000u); }
__device__ __forceinline__ float bf2f(bf16_t v) { return __uint_as_float((unsigned)v << 16); }
__device__ __forceinline__ float shfl_xor_l(float v, int o, int lane) { return __int_as_float(__builtin_amdgcn_ds_bpermute(4 * (lane ^ o), __float_as_int(v))); }
__device__ __forceinline__ int shfl_up_l(int v, int o, int lane) { return __builtin_amdgcn_ds_bpermute(4 * (lane - o), v); }
__device__ __forceinline__ float swap_sum(float v) { auto rr = __builtin_amdgcn_permlane32_swap(__float_as_uint(v), __float_as_uint(v), false, false); return __uint_as_float(rr[0]) + __uint_as_float(rr[1]); }
__device__ __forceinline__ float swap_max(float v) { auto rr = __builtin_amdgcn_permlane32_swap(__float_as_uint(v), __float_as_uint(v), false, false); return fmaxf(__uint_as_float(rr[0]), __uint_as_float(rr[1])); }
__device__ __forceinline__ void swap_both(float v, float& from_lo, float& from_hi) { auto rr = __builtin_amdgcn_permlane32_swap(__float_as_uint(v), __float_as_uint(v), false, false); from_lo = __uint_as_float(rr[0]); from_hi = __uint_as_float(rr[1]); }
__device__ __forceinline__ int crow(int r, int hi) { return (r & 3) + 8 * (r >> 2) + 4 * hi; }

namespace pg8 {
constexpr int BM = 256, BK = 64, HALF = 128, HTB = HALF * BK * 2, STAGE_BYTES = 8 * HTB;
__host__ __device__ __forceinline__ int lds_byte(int r, int c) { const int st = (r >> 4) * 2 + (c >> 5), rr = r & 15, cc = c & 31, ob = rr * 64 + cc * 2; return st * 1024 + (ob ^ (((ob >> 9) & 1) << 5)); }
__host__ __device__ __forceinline__ void stage_rc(int b, int& R, int& C) { const int st = b / 1024, sb = b % 1024, swz = sb ^ (((sb >> 9) & 1) << 5); R = (st >> 1) * 16 + swz / 64; C = (st & 1) * 32 + (swz % 64) / 2; }
__host__ __device__ __forceinline__ int perm32(int rho) { const int n = rho >> 4, i = rho & 15; return 8 * (i >> 2) + 4 * n + (i & 3); }

struct Unit { const char* a; const char* b; int pm, pn; int e, r0; int row0; int nv; int late; };
struct Gemm { int lda, ldb, K; };

struct DenseOrder {
    static constexpr bool GATHER_CAPABLE = false; static constexpr bool PARTIAL = false;
    __device__ __forceinline__ void acquire_late(int) const {}
    __device__ __forceinline__ unsigned row_off(const Unit&, int) const { return 0u; }
    __device__ __forceinline__ void row_off4(const Unit&, const int (&)[4], unsigned (&off)[4]) const { off[0] = off[1] = off[2] = off[3] = 0u; }
    const char* A; const char* Bt; int lda, ldb; int nM, nN, nwg, G, c; bool areal;
    __device__ void init(const void* A_, const void* Bt_, int lda_, int ldb_, int M, int N, int G_, int c_, bool areal_) { areal = areal_; A = (const char*)A_; Bt = (const char*)Bt_; lda = lda_; ldb = ldb_; nM = NB * (SEQ / BM); (void)M; nN = N / BM; nwg = nM * nN; G = G_; c = c_; }
    __device__ bool next(int i, Unit& u) const {
        const long L = (long)i * G + c; if (L >= nwg) return false;
        int wgid = (int)L; { const int q = nwg / 8, r = nwg % 8, xcd = wgid % 8, off = wgid / 8; wgid = (xcd < r ? xcd * (q + 1) : r * (q + 1) + (xcd - r) * q) + off; }
        const int nig = 8 * nN, gid = wgid / nig, fm = gid * 8, gsz = (nM - fm) < 8 ? (nM - fm) : 8;
        u.pm = fm + ((wgid % nig) % gsz); u.pn = (wgid % nig) / gsz;
        u.e = 0; u.r0 = 0; u.nv = BM; u.late = 0; u.row0 = (u.pm >> 4) * LSEQ + 128 + ((u.pm & 15) << 8);
        u.a = A + (size_t)(areal ? u.pm * BM : u.row0) * lda * 2; u.b = Bt + (size_t)u.pn * BM * ldb * 2; return true;
    }
};
struct GroupedOrder {
    static constexpr bool GATHER_CAPABLE = true; static constexpr bool PARTIAL = true;
    const char* A; const char* Bt; int lda, ldb; size_t bstride; const volatile LAS int* tstart; int ntile, G, c; const int* elist; const unsigned* cnt; bool gather;
    __device__ __forceinline__ void row_off4(const Unit& u, const int (&r)[4], unsigned (&off)[4]) const { const int n = tstart[64 + u.e]; int tok[4];
#pragma unroll
        for (int k = 0; k < 4; ++k) { const int i = u.r0 + r[k]; tok[k] = elist[(size_t)u.e * MROWS + (i < n ? i : 0)]; }
#pragma unroll
        for (int k = 0; k < 4; ++k) off[k] = (unsigned)((u.r0 + r[k] < n) ? tok[k] : HB_ZERO) * (unsigned)(lda * 2); }
    __device__ __forceinline__ unsigned row_off(const Unit& u, int r) const { const int i = u.r0 + r; const int n = tstart[64 + u.e];
        const int tok = elist[(size_t)u.e * MROWS + (i < n ? i : 0)]; return (i < n) ? (unsigned)tok * (unsigned)(lda * 2) : 0u; }
    int mode; const unsigned* latecnt;
    __device__ __forceinline__ void acquire_late(int tid) const {
        if (tid == 0) { const int total = ntile * 4, L = total - (total / G) * G;
            while (__hip_atomic_load(latecnt, __ATOMIC_RELAXED, __HIP_MEMORY_SCOPE_AGENT) < (unsigned)L) __builtin_amdgcn_s_sleep(8);
            __builtin_amdgcn_fence(__ATOMIC_ACQUIRE, "agent"); asm volatile("s_waitcnt vmcnt(0)" ::: "memory"); } }
    __device__ __forceinline__ void fill(int idx, Unit& u) const {
        const int tile = idx >> 2, pn = idx & 3, nf = tstart[NEXP]; int e = 0;
        if (tile < nf) { for (int k = 1; k < NEXP; ++k) e += (tstart[k] <= tile) ? 1 : 0; u.r0 = (tile - tstart[e]) * BM; u.nv = BM; }
        else { e = tstart[128 + tile - nf]; u.r0 = (tstart[e + 1] - tstart[e]) * BM; u.nv = tstart[64 + e] & (BM - 1); }
        u.pm = tile; u.pn = pn; u.e = e; u.late = 0; u.row0 = tile * BM; u.a = gather ? A : A + (size_t)tile * BM * lda * 2; u.b = Bt + (size_t)e * bstride + (size_t)pn * BM * ldb * 2;
    }
    __device__ __forceinline__ bool next(int i, Unit& u) const {
        const int v0 = (G % 8 == 0) ? (c % 8) * (G / 8) + c / 8 : c;
        const int total = ntile * 4, R = total / G, L = total - R * G;
        if (mode == 0) { if (i >= R) return false; fill(i * G + ((i & 1) ? G - 1 - v0 : v0), u); return true; }
        if (mode == 1) { if (i > 0 || v0 >= L) return false; fill(R * G + v0, u); return true; }
        const bool late = v0 < L; const int slot = late ? G - L + v0 : v0 - L, NN = R * G;
        auto normal = [&](int t) -> int { const int r = late ? t + 2 : t; const int w = (r < 2) ? G - L : G, off = (r < 2) ? r * (G - L) : 2 * (G - L) + (r - 2) * G; const int n = off + slot; return (slot < w && n < NN) ? n : -1; };
        const int n = normal(i);
        if (n >= 0) { fill(n, u); return true; }
        if (late && (i == 0 || normal(i - 1) >= 0)) { fill(NN + v0, u); u.late = 1; return true; }
        return false;
    }
};

struct EpiBf16 {
    static constexpr bool PERM = true;
    bf16_t* O; int ldc;
    __device__ __forceinline__ void operator()(const f32x4 (&acc)[2][2][4][2], const Unit& u, int wr, int wc, int fr, int fq) const {
        const int row0 = u.row0 + wr * 64 + fr, col0 = u.pn * BM + wc * 32 + 8 * fq;
#pragma unroll
        for (int ai = 0; ai < 2; ++ai) { if (u.nv <= ai * HALF + wr * 64) continue;
#pragma unroll
            for (int m = 0; m < 4; ++m) { bf16_t* rowp = O + (size_t)(row0 + ai * HALF + m * 16) * ldc + col0;
#pragma unroll
                for (int bj = 0; bj < 2; ++bj) { const f32x4 v0 = acc[ai][bj][m][0], v1 = acc[ai][bj][m][1];
                    u32x4 w; w.x = cvtpk(v0[0], v0[1]); w.y = cvtpk(v0[2], v0[3]); w.z = cvtpk(v1[0], v1[1]); w.w = cvtpk(v1[2], v1[3]);
                    *(u32x4*)(rowp + bj * HALF) = w; } } }
    }
};
struct EpiProj {
    static constexpr bool PERM = true;
    bf16_t* O; int ldc; const float* rsa;
    __device__ __forceinline__ void operator()(const f32x4 (&acc)[2][2][4][2], const Unit& u, int wr, int wc, int fr, int fq) const {
        const int row0 = u.row0 + wr * 64 + fr, col0 = u.pn * BM + wc * 32 + 8 * fq;
        float rsv[2][4];
#pragma unroll
        for (int ai = 0; ai < 2; ++ai)
#pragma unroll
            for (int m = 0; m < 4; ++m) rsv[ai][m] = rsa[u.pm * BM + wr * 64 + fr + ai * HALF + m * 16];
        __builtin_amdgcn_sched_barrier(0);
#pragma unroll
        for (int ai = 0; ai < 2; ++ai)
#pragma unroll
            for (int m = 0; m < 4; ++m) { bf16_t* rowp = O + (size_t)(row0 + ai * HALF + m * 16) * ldc + col0; const float rs = rsv[ai][m];
#pragma unroll
                for (int bj = 0; bj < 2; ++bj) { const f32x4 v0 = acc[ai][bj][m][0], v1 = acc[ai][bj][m][1];
                    u32x4 w; w.x = cvtpk(v0[0] * rs, v0[1] * rs); w.y = cvtpk(v0[2] * rs, v0[3] * rs); w.z = cvtpk(v1[0] * rs, v1[1] * rs); w.w = cvtpk(v1[2] * rs, v1[3] * rs);
                    *(u32x4*)(rowp + bj * HALF) = w; } }
    }
};
struct EpiSwiGLU {
    static constexpr bool PERM = true;
    bf16_t* H; int ldc; const float* rsl;
    __device__ __forceinline__ void operator()(const f32x4 (&acc)[2][2][4][2], const Unit& u, int wr, int wc, int fr, int fq) const {
        const int row0 = u.row0 + wr * 64 + fr, col0 = u.pn * HALF + wc * 32 + 8 * fq;
        float rsv[2][4];
#pragma unroll
        for (int ai = 0; ai < 2; ++ai)
#pragma unroll
            for (int m = 0; m < 4; ++m) rsv[ai][m] = rsl[(size_t)u.e * MROWS + u.r0 + wr * 64 + fr + ai * HALF + m * 16];
        __builtin_amdgcn_sched_barrier(0);
#pragma unroll
        for (int ai = 0; ai < 2; ++ai) { if (u.nv <= ai * HALF + wr * 64) continue;
#pragma unroll
            for (int m = 0; m < 4; ++m) { bf16_t* rowp = H + (size_t)(row0 + ai * HALF + m * 16) * ldc + col0; float o[8];
#pragma unroll
                for (int n = 0; n < 2; ++n)
#pragma unroll
                    for (int k = 0; k < 4; ++k) { const float g = acc[ai][0][m][n][k] * rsv[ai][m], up = acc[ai][1][m][n][k] * rsv[ai][m]; o[n * 4 + k] = g * __builtin_amdgcn_rcpf(1.0f + __builtin_amdgcn_exp2f(-g * LOG2E)) * up; }
                u32x4 w; w.x = cvtpk(o[0], o[1]); w.y = cvtpk(o[2], o[3]); w.z = cvtpk(o[4], o[5]); w.w = cvtpk(o[6], o[7]);
                *(u32x4*)rowp = w; } }
    }
};
struct EpiResid {
    static constexpr bool PERM = true;
    bf16_t* out;
    __device__ __forceinline__ void operator()(const f32x4 (&acc)[2][2][4][2], const Unit& u, int wr, int wc, int fr, int fq) const {
        const int col0 = u.pn * BM + wc * 32 + 8 * fq;
        bf16_t* o0 = out + (size_t)(u.pm * BM + wr * 64 + fr) * DM + col0;
        u32x4 w[2][4][2];
#pragma unroll
        for (int ai = 0; ai < 2; ++ai)
#pragma unroll
            for (int m = 0; m < 4; ++m)
#pragma unroll
                for (int bj = 0; bj < 2; ++bj) w[ai][m][bj] = *(const u32x4*)(o0 + (size_t)(ai * HALF + m * 16) * DM + bj * HALF);
        __builtin_amdgcn_sched_barrier(0);
#pragma unroll
        for (int ai = 0; ai < 2; ++ai)
#pragma unroll
            for (int m = 0; m < 4; ++m)
#pragma unroll
                for (int bj = 0; bj < 2; ++bj) { const u32x4 b = w[ai][m][bj];
                    const f32x4 v0 = acc[ai][bj][m][0] + (f32x4){bf_lo(b.x), bf_hi(b.x), bf_lo(b.y), bf_hi(b.y)}, v1 = acc[ai][bj][m][1] + (f32x4){bf_lo(b.z), bf_hi(b.z), bf_lo(b.w), bf_hi(b.w)};
                    u32x4 o; o.x = cvtpk(v0[0], v0[1]); o.y = cvtpk(v0[2], v0[3]); o.z = cvtpk(v1[0], v1[1]); o.w = cvtpk(v1[2], v1[3]);
                    *(u32x4*)(o0 + (size_t)(ai * HALF + m * 16) * DM + bj * HALF) = o; }
    }
};

template <bool GATHER, class Epi, class Sched>
__device__ __forceinline__ void gemm_phase(int tid, LAS unsigned char* lds, const Gemm g, const Sched& S, const Epi& E) {
    const int wid = __builtin_amdgcn_readfirstlane(tid >> 6), lane = tid & 63, wr = wid >> 2, wc = wid & 3, fr = lane & 15, fq = lane >> 4;
    const int K = g.K, nt = K / BK;
    unsigned voffA0[2], voffA1[2], nA0[2], nA1[2], voffB[2];
    const size_t hstepB = (size_t)HALF * g.ldb * 2;
#pragma unroll
    for (int i = 0; i < 2; ++i) { int R, C; stage_rc(tid * 16 + i * 8192, R, C); const int Rb = Epi::PERM ? ((R & ~31) + perm32(R & 31)) : R;
        voffA0[i] = (unsigned)(R * g.lda + C) * 2u; voffA1[i] = voffA0[i] + (unsigned)(HALF * g.lda * 2); nA0[i] = voffA0[i]; nA1[i] = voffA1[i]; voffB[i] = (unsigned)(Rb * g.ldb + C) * 2u; }
    const size_t kstep = (size_t)(BK * 2);
    const unsigned ldsw = (unsigned)wid * 1024u;
    const int aoff = lds_byte(wr * 64 + fr, fq * 8), boff = lds_byte(wc * 32 + fr, fq * 8);
#define PG8_SA(b, h) (((b) * 2 + (h)) * HTB)
#define PG8_SB(b, h) ((4 + (b) * 2 + (h)) * HTB)
#define PG8_STAGE(bufoff, gbase, voff) do { _Pragma("unroll") for (int _i = 0; _i < 2; ++_i) \
        __builtin_amdgcn_global_load_lds((const unsigned*)((const char*)(gbase) + (voff)[_i]), (LAS unsigned*)(lds + (bufoff) + ldsw + _i * 8192), 16, 0, 0); } while (0)
#define PG8_LDA(dst, b, h) do { _Pragma("unroll") for (int m = 0; m < 4; ++m) _Pragma("unroll") for (int k = 0; k < 2; ++k) dst[m][k] = *(const LAS bf16x8*)(lds + PG8_SA(b, h) + aoff + m * 2048 + k * 1024); } while (0)
#define PG8_LDB(dst, b, h) do { _Pragma("unroll") for (int n = 0; n < 2; ++n) _Pragma("unroll") for (int k = 0; k < 2; ++k) dst[n][k] = *(const LAS bf16x8*)(lds + PG8_SB(b, h) + boff + n * 2048 + k * 1024); } while (0)
#define PG8_MMA(ai, bj, At, Bt) do { __builtin_amdgcn_s_setprio(1); _Pragma("unroll") for (int m = 0; m < 4; ++m) _Pragma("unroll") for (int n = 0; n < 2; ++n) _Pragma("unroll") for (int k = 0; k < 2; ++k) \
        acc[ai][bj][m][n] = __builtin_amdgcn_mfma_f32_16x16x32_bf16(Bt[n][k], At[m][k], acc[ai][bj][m][n], 0, 0, 0); __builtin_amdgcn_s_setprio(0); } while (0)
#define PG8_WAIT_V(n) asm volatile("s_waitcnt vmcnt(" #n ")" ::: "memory")
#define PG8_WAIT_V8_UNLESS(c) asm volatile("s_cmp_lg_u32 %0, 0\n\ts_cbranch_scc1 1f\n\ts_waitcnt vmcnt(8)\n1:" :: "s"(c) : "memory", "scc")
#define PG8_WAIT_L(n) asm volatile("s_waitcnt lgkmcnt(" #n ")" ::: "memory")
#define PG8_BAR __builtin_amdgcn_s_barrier()
#define PG8_SCHED __builtin_amdgcn_sched_barrier(0)
    Unit cur, nxt; int ui = 0;
    if (!S.next(0, cur)) return;
    if (Sched::PARTIAL && cur.late) { S.acquire_late(tid); __syncthreads(); }
    f32x4 acc[2][2][4][2];
#pragma unroll
    for (int a = 0; a < 2; ++a)
#pragma unroll
        for (int b = 0; b < 2; ++b)
#pragma unroll
            for (int m = 0; m < 4; ++m)
#pragma unroll
                for (int n = 0; n < 2; ++n) acc[a][b][m][n] = (f32x4){0.f, 0.f, 0.f, 0.f};
    bf16x8 At[4][2], B0[2][2], B1[2][2];
    const char* cA = cur.a; const char* cB = cur.b;
    if (GATHER) { int RA[2], CA[2]; { int tl_ = tid; asm volatile("" : "+v"(tl_)); stage_rc(tl_ * 16, RA[0], CA[0]); stage_rc(tl_ * 16 + 8192, RA[1], CA[1]); }     const int r4[4] = {RA[0], RA[1], HALF + RA[0], HALF + RA[1]}; unsigned o4[4]; S.row_off4(cur, r4, o4);
        voffA0[0] = o4[0] + (unsigned)(CA[0] * 2); voffA0[1] = o4[1] + (unsigned)(CA[1] * 2); voffA1[0] = o4[2] + (unsigned)(CA[0] * 2); voffA1[1] = o4[3] + (unsigned)(CA[1] * 2); }
    PG8_STAGE(PG8_SB(0, 0), cB, voffB); PG8_STAGE(PG8_SB(0, 1), cB + hstepB, voffB); PG8_STAGE(PG8_SA(0, 0), cA, voffA0); PG8_STAGE(PG8_SA(0, 1), cA, voffA1);
    if (wr == 1) PG8_BAR;
    PG8_WAIT_V(2); PG8_BAR;
    PG8_STAGE(PG8_SB(1, 0), cB + kstep, voffB); PG8_STAGE(PG8_SA(1, 0), cA + kstep, voffA0); PG8_STAGE(PG8_SB(1, 1), cB + hstepB + kstep, voffB);
    PG8_WAIT_V(6); PG8_BAR;
    for (;;) {
        const bool has_next = S.next(ui + 1, nxt);
        if (Sched::PARTIAL && has_next && nxt.late) S.acquire_late(tid);
        const char* nA = has_next ? nxt.a : cA; const char* nB = has_next ? nxt.b : cB;
        if (GATHER) { if (has_next) { int RA[2], CA[2]; { int tl_ = tid; asm volatile("" : "+v"(tl_)); stage_rc(tl_ * 16, RA[0], CA[0]); stage_rc(tl_ * 16 + 8192, RA[1], CA[1]); }     const int r4[4] = {RA[0], RA[1], HALF + RA[0], HALF + RA[1]}; unsigned o4[4]; S.row_off4(nxt, r4, o4);
                nA0[0] = o4[0] + (unsigned)(CA[0] * 2); nA0[1] = o4[1] + (unsigned)(CA[1] * 2); nA1[0] = o4[2] + (unsigned)(CA[0] * 2); nA1[1] = o4[3] + (unsigned)(CA[1] * 2); }
            else { nA0[0] = voffA0[0]; nA0[1] = voffA0[1]; nA1[0] = voffA1[0]; nA1[1] = voffA1[1]; } }
        constexpr bool act0 = true, act1 = true;
        for (int t = 0; t < nt; t += 2) {
            const bool last = (t == nt - 2); const int fresh = __builtin_amdgcn_readfirstlane((t == 0 && ui > 0) ? 1 : 0);
            const char* a1 = cA + (size_t)(t + 1) * kstep;
            const char* a2 = last ? nA : cA + (size_t)(t + 2) * kstep; const char* b2 = last ? nB : cB + (size_t)(t + 2) * kstep;
            const char* a3 = a2 + kstep; const char* b3 = b2 + kstep;
            unsigned x0[2], x1[2];
#pragma unroll
            for (int i = 0; i < 2; ++i) { x0[i] = (GATHER && last) ? nA0[i] : voffA0[i]; x1[i] = (GATHER && last) ? nA1[i] : voffA1[i]; }
            PG8_LDB(B0, 0, 0); PG8_LDB(B1, 0, 1); PG8_SCHED; PG8_LDA(At, 0, 0); PG8_STAGE(PG8_SA(1, 1), a1, voffA1);
            PG8_WAIT_V8_UNLESS(fresh); PG8_WAIT_L(0); PG8_BAR; if (act0) { PG8_MMA(0, 0, At, B0); PG8_MMA(0, 1, At, B1); } PG8_BAR; PG8_SCHED;
            PG8_LDA(At, 0, 1); PG8_STAGE(PG8_SB(0, 0), b2, voffB); PG8_STAGE(PG8_SB(0, 1), b2 + hstepB, voffB); PG8_STAGE(PG8_SA(0, 0), a2, x0);
            PG8_WAIT_V8_UNLESS(fresh); PG8_WAIT_L(0); PG8_BAR; if (act1) { PG8_MMA(1, 0, At, B0); PG8_MMA(1, 1, At, B1); } PG8_BAR; PG8_SCHED;
            PG8_LDB(B0, 1, 0); PG8_LDB(B1, 1, 1); PG8_SCHED; PG8_LDA(At, 1, 0); PG8_STAGE(PG8_SA(0, 1), a2, x1);
            PG8_WAIT_V(8); PG8_WAIT_L(0); PG8_BAR; if (act0) { PG8_MMA(0, 0, At, B0); PG8_MMA(0, 1, At, B1); } PG8_BAR; PG8_SCHED;
            PG8_LDA(At, 1, 1); PG8_STAGE(PG8_SB(1, 0), b3, voffB); PG8_STAGE(PG8_SB(1, 1), b3 + hstepB, voffB); PG8_STAGE(PG8_SA(1, 0), a3, x0);
            PG8_WAIT_V(8); PG8_WAIT_L(0); PG8_BAR; if (act1) { PG8_MMA(1, 0, At, B0); PG8_MMA(1, 1, At, B1); } PG8_BAR; PG8_SCHED;
        }
        PG8_WAIT_V(0);
        if (wr == 0) PG8_BAR;
        E(acc, cur, wr, wc, fr, fq);
        if (!has_next) break;
#pragma unroll
        for (int a = 0; a < 2; ++a)
#pragma unroll
            for (int b = 0; b < 2; ++b)
#pragma unroll
                for (int m = 0; m < 4; ++m)
#pragma unroll
                    for (int n = 0; n < 2; ++n) acc[a][b][m][n] = (f32x4){0.f, 0.f, 0.f, 0.f};
        cur = nxt; cA = nA; cB = nB; ++ui;
        if (GATHER) {
#pragma unroll
            for (int i = 0; i < 2; ++i) { voffA0[i] = nA0[i]; voffA1[i] = nA1[i]; } }
        if (wr == 1) PG8_BAR;
    }
    PG8_WAIT_V(0);
    PG8_BAR;
#undef PG8_SA
#undef PG8_SB
#undef PG8_STAGE
#undef PG8_LDA
#undef PG8_LDB
#undef PG8_MMA
#undef PG8_WAIT_V
#undef PG8_WAIT_L
#undef PG8_BAR
#undef PG8_SCHED
}
}

struct Args {
    const float* in[20]; float* out; unsigned char* ws; int ph_lo, ph_hi;
};
struct Frame {
    LAS unsigned char* lds; volatile LAS int* MISC;
    int tid, lane, wave, G, gw, NGW;
};

__constant__ float INV_FREQ[16] = {1.0f, 0.5623413251903491f, 0.31622776601683794f, 0.1778279410038923f, 0.1f, 0.05623413251903491f, 0.03162277660168379f, 0.01778279410038923f,
                                   0.01f, 0.005623413251903491f, 0.003162277660168379f, 0.001778279410038923f, 0.001f, 0.0005623413251903491f, 0.00031622776601683794f, 0.00017782794100389227f};

__device__ __forceinline__ void transpose_item(const float* W, int N, int k0, int scol0, int nvalid, const float* kscale, bf16_t* WT, int K, int drow0, LAS float* scr, int lane) {
    const int j = lane & 31;
    if (nvalid == 0) {
#pragma unroll
        for (int i = 0; i < 32; ++i) scr[(2 * i + (lane >> 5)) * 33 + j] = 0.f;
    } else {
        const int jc = j < nvalid ? j : 0;
        const float* src = W + (size_t)(k0 + (lane >> 5)) * N + scol0 + jc;
        float t[32];
#pragma unroll
        for (int i = 0; i < 32; ++i) t[i] = src[(size_t)(2 * i) * N];
#pragma unroll
        for (int i = 0; i < 32; ++i) { const int kk = 2 * i + (lane >> 5); float v = (j < nvalid) ? t[i] : 0.f; if (kscale) v *= kscale[k0 + kk]; scr[kk * 33 + j] = v; }
    }
    asm volatile("s_waitcnt lgkmcnt(0)" ::: "memory");
    const int c = lane & 7;
#pragma unroll
    for (int q = 0; q < 4; ++q) { const int n = (lane >> 3) + 8 * q; const LAS float* s = scr + (8 * c) * 33 + n;
        u32x4 o; o.x = cvtpk(s[0 * 33], s[1 * 33]); o.y = cvtpk(s[2 * 33], s[3 * 33]); o.z = cvtpk(s[4 * 33], s[5 * 33]); o.w = cvtpk(s[6 * 33], s[7 * 33]);
        *(u32x4*)(WT + (size_t)(drow0 + n) * K + k0 + 8 * c) = o; }
    asm volatile("s_waitcnt lgkmcnt(0)" ::: "memory");
}
template <class Map>
__device__ __forceinline__ void transpose_matrix(Frame& F, int& base, int it, const float* W, int K, int N, int Ndst, const float* kscale, bf16_t* WT, const Map& map, LAS float* scr, bool& done) {
    const int nblk = Ndst / 32, items = (K / 64) * nblk;
    if (!done && it >= base && it < base + items) { const int r = it - base, kb = r / nblk, nb = r % nblk; int scol0, nvalid, drow0; map(nb, scol0, nvalid, drow0);
        transpose_item(W, N, 64 * kb, scol0, nvalid, kscale, WT, K, drow0, scr, F.lane); done = true; }
    base += items;
}


struct XwItem { const float* src; int N; int k0; int scol; bf16_t* dst; int K; int drow0; const float* gain; };
__device__ __forceinline__ XwItem xw_decode(int it, const float* wg, const float* wu, const float* wd, const float* gain, bf16_t* gu_t, bf16_t* dn_t) {
    constexpr int per_gu = (1024 / 64) * (1024 / 32), items_gu = NEXP * per_gu, per_dn = (512 / 64) * (1024 / 32);
    XwItem x;
    if (it < items_gu) { const int e = it / per_gu, q = it % per_gu, kb = q / 32, nb = q % 32;
        const int pn = nb >> 3, within = nb & 7; const bool up = within >= 4;
        x.src = (up ? wu : wg) + (size_t)e * 1024 * 512; x.N = 512; x.k0 = 64 * kb; x.scol = 128 * pn + 32 * (within & 3); x.dst = gu_t + (size_t)e * 1024 * 1024; x.K = 1024; x.drow0 = 32 * nb; x.gain = gain; }
    else { const int r = it - items_gu, e = r / per_dn, q = r % per_dn, kb = q / 32, nb = q % 32;
        x.src = wd + (size_t)e * 512 * 1024; x.N = 1024; x.k0 = 64 * kb; x.scol = 32 * nb; x.dst = dn_t + (size_t)e * 1024 * 512; x.K = 512; x.drow0 = 32 * nb; x.gain = nullptr; }
    return x;
}
__device__ __forceinline__ void xw_load(const XwItem& x, int lane, float (&t)[32]) {
    const float* src = x.src + (size_t)(x.k0 + (lane >> 5)) * x.N + x.scol + (lane & 31);
#pragma unroll
    for (int i = 0; i < 32; ++i) t[i] = __builtin_nontemporal_load(src + (size_t)(2 * i) * x.N);
}
__device__ __forceinline__ void xw_finish(const XwItem& x, int lane, const float (&t)[32], LAS float* scr) {
    const int j = lane & 31, c = lane & 7;
    f32x4 g0 = {1.f, 1.f, 1.f, 1.f}, g1 = g0;
    if (x.gain) { g0 = *(const f32x4*)(x.gain + x.k0 + 8 * c); g1 = *(const f32x4*)(x.gain + x.k0 + 8 * c + 4); }
#pragma unroll
    for (int i = 0; i < 32; ++i) scr[(2 * i + (lane >> 5)) * 33 + j] = t[i];
    asm volatile("s_waitcnt lgkmcnt(0)" ::: "memory");
#pragma unroll
    for (int q = 0; q < 4; ++q) { const int n = (lane >> 3) + 8 * q; const LAS float* sp = scr + (8 * c) * 33 + n;
        u32x4 o; o.x = cvtpk(sp[0 * 33] * g0[0], sp[1 * 33] * g0[1]); o.y = cvtpk(sp[2 * 33] * g0[2], sp[3 * 33] * g0[3]); o.z = cvtpk(sp[4 * 33] * g1[0], sp[5 * 33] * g1[1]); o.w = cvtpk(sp[6 * 33] * g1[2], sp[7 * 33] * g1[3]);
        __builtin_nontemporal_store(o, (u32x4*)(x.dst + (size_t)(x.drow0 + n) * x.K + x.k0 + 8 * c)); }
    asm volatile("s_waitcnt lgkmcnt(0)" ::: "memory");
}
constexpr int XW_ITEMS = NEXP * ((1024 / 64) * (1024 / 32) + (512 / 64) * (1024 / 32)), XW_PER_WAVE = 12, XW_WG_ITEMS = XW_ITEMS / (NWAVES * XW_PER_WAVE);
static_assert(XW_WG_ITEMS * NWAVES * XW_PER_WAVE == XW_ITEMS, "expert conversion items");
__device__ __forceinline__ void xw_wg_item(int q, int wave, int lane, const float* wg, const float* wu, const float* wd, const float* gain, bf16_t* gu_t, bf16_t* dn_t, LAS float* scr) {
    const int it0 = (q * NWAVES + wave) * XW_PER_WAVE;
    float ta[32], tb[32];
    XwItem xa = xw_decode(it0, wg, wu, wd, gain, gu_t, dn_t), xb = xa;
    xw_load(xa, lane, ta);
#pragma unroll 1
    for (int k = 0; k < XW_PER_WAVE; k += 2) {
        xb = xw_decode(it0 + k + 1, wg, wu, wd, gain, gu_t, dn_t); xw_load(xb, lane, tb);
        xw_finish(xa, lane, ta, scr);
        if (k + 2 < XW_PER_WAVE) { xa = xw_decode(it0 + k + 2, wg, wu, wd, gain, gu_t, dn_t); xw_load(xa, lane, ta); }
        xw_finish(xb, lane, tb, scr);
    }
}

__device__ __forceinline__ float* hrow_ptr(float* out_real, float* h_meta, int m) { const int b = m / LSEQ, p = m - b * LSEQ; return p < 128 ? h_meta + (size_t)(b * 16 + (p - PADF)) * DM : out_real + (size_t)(b * SEQ + (p - 128)) * DM; }

__device__ __forceinline__ void store_xn_row(bf16_t* orow, const f32x4 (&v)[4], float rs, const f32x4 (&gg)[4], int lane) {
    u32x2* o8 = (u32x2*)orow + lane;
#pragma unroll
    for (int j = 0; j < 4; ++j) { u32x2 w; w.x = cvtpk(v[j].x * rs * gg[j].x, v[j].y * rs * gg[j].y); w.y = cvtpk(v[j].z * rs * gg[j].z, v[j].w * rs * gg[j].w); o8[64 * j] = w; }
}
__device__ __forceinline__ void zero_xn_row(bf16_t* orow, int lane) { u32x2* o8 = (u32x2*)orow + lane;
#pragma unroll
    for (int j = 0; j < 4; ++j) o8[64 * j] = (u32x2){0u, 0u}; }

__device__ __forceinline__ void moe_combine_row(f32x4 (&v)[4], const bf16_t* yrows, const int* tokp, const float* tokw, int m, int lane) {
    const int s0 = tokp[2 * m], s1 = tokp[2 * m + 1]; const float w0 = tokw[2 * m], w1 = tokw[2 * m + 1];
    const u32x2* y0 = (const u32x2*)(yrows + (size_t)s0 * DM) + lane; const u32x2* y1 = (const u32x2*)(yrows + (size_t)s1 * DM) + lane;
#pragma unroll
    for (int j = 0; j < 4; ++j) { const u32x2 a = y0[64 * j], b = y1[64 * j];
        v[j].x += w0 * bf_lo(a.x) + w1 * bf_lo(b.x); v[j].y += w0 * bf_hi(a.x) + w1 * bf_hi(b.x); v[j].z += w0 * bf_lo(a.y) + w1 * bf_lo(b.y); v[j].w += w0 * bf_hi(a.y) + w1 * bf_hi(b.y); }
}


struct NormCtx { const float* x; const float* meta; float* out; float* hmeta; bf16_t* hb; const float* g; float* rsa; const bf16_t* yrows; const int* toke; const int* tokp; const float* tokw; const volatile LAS int* tstart; };
template <int MODE, int NR>
__device__ __forceinline__ void norm_rows(const NormCtx& C, int m0, int mend, int lane) {
    f32x4 v[NR][4]; bool valid[NR]; float* hp[NR]; bf16_t* hbp[NR];
    f32x4 gg[4];
    if (MODE == 2) {
#pragma unroll
        for (int j = 0; j < 4; ++j) gg[j] = *((const f32x4*)C.g + lane + 64 * j); }
#pragma unroll
    for (int r = 0; r < NR; ++r) { const int m = m0 + r; valid[r] = false; hp[r] = nullptr; hbp[r] = nullptr;
        if (m < mend) {
            if (MODE == 2) { valid[r] = true; hp[r] = C.out + (size_t)m * DM; hbp[r] = C.hb + (size_t)m * DM; }
            else { const int b = m / LSEQ, p = m - b * LSEQ; valid[r] = (p >= PADF);
                if (valid[r]) { if (MODE == 0) hp[r] = (float*)(p < 128 ? C.meta + (size_t)(p - PADF) * DM : C.x + (size_t)(b * SEQ + p - 128) * DM);
                    else if (p < 128) hp[r] = C.hmeta + (size_t)(b * 16 + (p - PADF)) * DM; else hbp[r] = C.hb + (size_t)(b * SEQ + (p - 128)) * DM; } }
            if (valid[r]) {
                if (hbp[r]) { const u32x2* xr = (const u32x2*)hbp[r] + lane;
#pragma unroll
                    for (int j = 0; j < 4; ++j) { const u32x2 w = xr[64 * j]; v[r][j] = (f32x4){bf_lo(w.x), bf_hi(w.x), bf_lo(w.y), bf_hi(w.y)}; } }
                else { const f32x4* xr = (const f32x4*)hp[r] + lane;
#pragma unroll
                    for (int j = 0; j < 4; ++j) v[r][j] = __builtin_nontemporal_load(xr + 64 * j); } }
        } }
    if (MODE == 0) {
#pragma unroll
        for (int r = 0; r < NR; ++r) { const int m = m0 + r; const int b = m / LSEQ, p = m - b * LSEQ;
            if (m < mend && p >= PADF) { u32x2* hr = (u32x2*)(C.hb + (size_t)(p >= 128 ? b * SEQ + (p - 128) : HB_META + b * 16 + (p - PADF)) * DM) + lane;
#pragma unroll
                for (int j = 0; j < 4; ++j) hr[64 * j] = (u32x2){cvtpk(v[r][j].x, v[r][j].y), cvtpk(v[r][j].z, v[r][j].w)}; } }
    }
    if (MODE == 1 || MODE == 2) {
        u32x2 ya[NR][4], yb[NR][4]; float w0[NR], w1[NR]; int e0[NR], e1[NR], q0[NR], q1[NR];
#pragma unroll
        for (int r = 0; r < NR; ++r) { e0[r] = e1[r] = q0[r] = q1[r] = 0; w0[r] = w1[r] = 0.f;
            if (valid[r]) { int mt = m0 + r; if (MODE == 2) { const int b = mt / SEQ; mt = b * LSEQ + 128 + (mt - b * SEQ); }
                e0[r] = C.toke[2 * mt]; e1[r] = C.toke[2 * mt + 1]; q0[r] = C.tokp[2 * mt]; q1[r] = C.tokp[2 * mt + 1]; w0[r] = C.tokw[2 * mt]; w1[r] = C.tokw[2 * mt + 1]; } }
#pragma unroll
        for (int r = 0; r < NR; ++r) if (valid[r]) {
            const int f0 = (C.tstart[e0[r] + 1] - C.tstart[e0[r]]) * 256, f1 = (C.tstart[e1[r] + 1] - C.tstart[e1[r]]) * 256;
            const int s0 = q0[r] < f0 ? C.tstart[e0[r]] * 256 + q0[r] : C.tstart[96 + e0[r]] * 256 + (q0[r] - f0), s1 = q1[r] < f1 ? C.tstart[e1[r]] * 256 + q1[r] : C.tstart[96 + e1[r]] * 256 + (q1[r] - f1);
            const u32x2* y0 = (const u32x2*)(C.yrows + (size_t)s0 * DM) + lane; const u32x2* y1 = (const u32x2*)(C.yrows + (size_t)s1 * DM) + lane;
#pragma unroll
            for (int j = 0; j < 4; ++j) { ya[r][j] = __builtin_nontemporal_load(y0 + 64 * j); yb[r][j] = __builtin_nontemporal_load(y1 + 64 * j); } }
#pragma unroll
        for (int r = 0; r < NR; ++r) if (valid[r]) {
#pragma unroll
            for (int j = 0; j < 4; ++j) { const u32x2 a = ya[r][j], b = yb[r][j];
                v[r][j].x += w0[r] * bf_lo(a.x) + w1[r] * bf_lo(b.x); v[r][j].y += w0[r] * bf_hi(a.x) + w1[r] * bf_hi(b.x); v[r][j].z += w0[r] * bf_lo(a.y) + w1[r] * bf_lo(b.y); v[r][j].w += w0[r] * bf_hi(a.y) + w1[r] * bf_hi(b.y); }
            if (MODE == 1) {
                if (hbp[r]) { u32x2* hr = (u32x2*)hbp[r] + lane;
#pragma unroll
                    for (int j = 0; j < 4; ++j) hr[64 * j] = (u32x2){cvtpk(v[r][j].x, v[r][j].y), cvtpk(v[r][j].z, v[r][j].w)}; }
                else { f32x4* hr = (f32x4*)hp[r] + lane; const int mm = m0 + r, bb = mm / LSEQ, pp = mm - bb * LSEQ; u32x2* hc = (u32x2*)(C.hb + (size_t)(HB_META + bb * 16 + (pp - PADF)) * DM) + lane;
#pragma unroll
                    for (int j = 0; j < 4; ++j) { hr[64 * j] = v[r][j]; hc[64 * j] = (u32x2){cvtpk(v[r][j].x, v[r][j].y), cvtpk(v[r][j].z, v[r][j].w)}; } } } }
    }
    float ss[NR];
#pragma unroll
    for (int r = 0; r < NR; ++r) { ss[r] = 0.f; if (valid[r]) {
#pragma unroll
        for (int j = 0; j < 4; ++j) ss[r] += (v[r][j].x * v[r][j].x + v[r][j].y * v[r][j].y) + (v[r][j].z * v[r][j].z + v[r][j].w * v[r][j].w); } }
#pragma unroll
    for (int o = 1; o < 64; o <<= 1) {
#pragma unroll
        for (int r = 0; r < NR; ++r) ss[r] += shfl_xor_l(ss[r], o, lane); }
#pragma unroll
    for (int r = 0; r < NR; ++r) { const int m = m0 + r; if (m >= mend) continue;
        const float rs = __builtin_amdgcn_rsqf(ss[r] * (1.0f / DM) + EPS);
        if (MODE == 2) { f32x4* hr = (f32x4*)hp[r] + lane;
#pragma unroll
            for (int j = 0; j < 4; ++j) hr[64 * j] = (f32x4){v[r][j].x * rs * gg[j].x, v[r][j].y * rs * gg[j].y, v[r][j].z * rs * gg[j].z, v[r][j].w * rs * gg[j].w}; }
        else if (valid[r] && lane == 0) { const int b = m / LSEQ, p = m - b * LSEQ; C.rsa[p >= 128 ? b * SEQ + (p - 128) : NB * SEQ + b * 16 + (p - PADF)] = rs; } }
}

constexpr int AT_KP = 208;
constexpr int AT_KBUF = 64 * AT_KP, AT_VBUF = 8192, AT_FBUF = 256;
constexpr int AT_K0 = 0, AT_V0 = 4 * AT_KBUF, AT_F0 = AT_V0 + 4 * AT_VBUF, AT_END = AT_F0 + 4 * AT_FBUF;
static_assert(AT_END + 64 <= RING_BYTES, "attention LDS (+ 2 x 8 wave flags)");
struct AttnArgs { const bf16_t* proj; const bf16_t* qm; const bf16_t* km; const bf16_t* vm; const float* negf; const float* sinks; bf16_t* y; };

template <int VAR>
__device__ __forceinline__ void attn_unit(int tid, const AttnArgs& T, int b, int h, int u, LAS unsigned char* lds) {
    constexpr int DK = (VAR == 2) ? 96 : 64, NDS = DK / 16, KCH = DK / 8, KPB = DK * 2 + 16;
    const int lane = tid & 63, rr = lane & 31, hi = lane >> 5; const int wid = __builtin_amdgcn_readfirstlane(tid >> 6);
    const bf16_t *Qb, *Kb, *Vb; int qpitch, kpitch, vpitch;
    if (VAR == 0) { Qb = T.proj + C_AQ + 64 * h; Kb = T.proj + C_AK + 64 * (h >> 1); Vb = T.proj + C_AV + 64 * (h >> 1); qpitch = kpitch = vpitch = NPROJ; }
    else if (VAR == 1) { Qb = T.proj + C_FQ + 64 * h; Kb = T.proj + C_FK + 64 * h; Vb = T.proj + C_FV + 64 * h; qpitch = kpitch = vpitch = NPROJ; }
    else if (VAR == 2) { Qb = T.qm + 96 * h; Kb = T.km + 96 * h; Vb = T.vm + 64 * h; qpitch = kpitch = 384; vpitch = 256; }
    else { Qb = T.proj + C_SQ + 64 * h; Kb = T.proj + C_SK + 64 * h; Vb = T.proj + C_SV + 64 * h; qpitch = kpitch = vpitch = NPROJ; }
    const size_t rowb = (size_t)b * LSEQ;
    const int pq0 = (u < 0 ? -128 : 128 + 256 * u) + 32 * wid;
    const int pq = pq0 + rr;
    const bool wave_on = (pq0 + 31 >= PADF);
    const int cq = (u < 0) ? 0 : 4 * u + 1 + (wid >> 1);
    int ntile, t_first, t_step;
    if (u < 0) { ntile = 1; t_first = 1; t_step = 1; }
    else if (VAR == 0) { t_first = (u == 0) ? 2 : 4 * u; ntile = 4 * u + 5 - t_first + 2; t_step = 1; }
    else if (VAR == 3 || VAR == 1) { ntile = 4 * u + 5; t_first = 4 * u + 5; t_step = -1; }
    else { ntile = 4 * u + 5; t_first = 1; t_step = 1; }
#define TILE_OF(i) ((VAR == 0 && u >= 0) ? ((i) == 0 ? 1 : t_first + (i) - 1) : t_first + t_step * (i))
    bf16x8 qf[NDS];
    { const int pl = pq < 0 ? 0 : pq; const bf16_t* qrow = Qb + (rowb + pl) * qpitch + 8 * hi;
#pragma unroll
      for (int ds = 0; ds < NDS; ++ds) qf[ds] = *(const bf16x8*)(qrow + 16 * ds); }
    const int kr0 = tid / KCH, kc0 = tid % KCH;
    const int kr1 = (tid + 512) / KCH, kc1 = (tid + 512) % KCH;
    const bool k2 = (DK == 96) && (tid < 256);
    const int vr = tid >> 3, vc = tid & 7;
    const int v_lds = (vr >> 3) * 1024 + (vc >> 2) * 512 + (vr & 7) * 64 + (vc & 3) * 16;
    u32x4 kreg0a, kreg1a, vrega, kreg0b, kreg1b, vregb; f32x4 frega, fregb;
    kreg1a = (u32x4){0u, 0u, 0u, 0u}; kreg1b = kreg1a; frega = (f32x4){0.f, 0.f, 0.f, 0.f}; fregb = frega;
#define AT_LOAD(S_, j) do { const size_t r0_ = rowb + 64 * (size_t)(j); \
        kreg0##S_ = *(const u32x4*)(Kb + (r0_ + kr0) * kpitch + 8 * kc0); if (k2) kreg1##S_ = *(const u32x4*)(Kb + (r0_ + kr1) * kpitch + 8 * kc1); \
        vreg##S_ = *(const u32x4*)(Vb + (r0_ + vr) * vpitch + 8 * vc); \
        if (VAR == 1 && tid < 16) freg##S_ = *(const f32x4*)(T.negf + ((size_t)(b * 4 + h) * LSEQ + 64 * (j)) + 4 * tid); } while (0)
#define AT_WRITE(S_, buf) do { *(LAS u32x4*)(lds + AT_K0 + (buf) * AT_KBUF + kr0 * KPB + kc0 * 16) = kreg0##S_; if (k2) *(LAS u32x4*)(lds + AT_K0 + (buf) * AT_KBUF + kr1 * KPB + kc1 * 16) = kreg1##S_; \
        *(LAS u32x4*)(lds + AT_V0 + (buf) * AT_VBUF + v_lds) = vreg##S_; if (VAR == 1 && tid < 16) *(LAS f32x4*)(lds + AT_F0 + (buf) * AT_FBUF + 16 * tid) = freg##S_; } while (0)
    constexpr float ATT_THR = 8.0f;
    const float cs = ((VAR == 2) ? 0.10206207261596575f : 0.125f) * LOG2E;
#pragma unroll
    for (int ds = 0; ds < NDS; ++ds) { u32x4 w = __builtin_bit_cast(u32x4, qf[ds]);
#pragma unroll
        for (int k = 0; k < 4; ++k) w[k] = cvtpk(bf_lo(w[k]) * cs, bf_hi(w[k]) * cs);
        qf[ds] = __builtin_bit_cast(bf16x8, w); }
    float mhat = 0.f, l_run = 0.f, R_run = 1.0f, slope2 = 0.f; bool wave_dead = false;
    if (VAR == 0) { l_run = (hi == 0) ? __builtin_amdgcn_exp2f(T.sinks[h] * LOG2E) : 0.f; slope2 = __builtin_amdgcn_exp2f(-2.0f * (float)(h + 1)) * LOG2E; }
    f32x16 o0 = {}, o1 = {};
    const int vbase = (4 * hi + ((lane & 15) >> 2)) * 64 + ((lane >> 4) & 1) * 32 + (lane & 3) * 8;
    AT_LOAD(a, TILE_OF(0)); if (ntile > 1) AT_LOAD(b, TILE_OF(1));
    AT_WRITE(a, 0); if (ntile > 1) AT_WRITE(b, 1);
    __syncthreads();
    auto compute_tile = [&](const int j, const int buf) __attribute__((always_inline)) {
        const int cj = j - 1;
        bool doit = wave_on && (cj <= cq) && !wave_dead;
        if (VAR == 0) doit = doit && (j == 1 || cj >= cq - 2);
        if (doit) {
            const LAS unsigned char* Kt = lds + AT_K0 + buf * AT_KBUF; const LAS unsigned char* Vt = lds + AT_V0 + buf * AT_VBUF;
            f32x16 p0, p1;
            { const float nm = (VAR == 3) ? 0.f : -mhat;
#pragma unroll
              for (int r = 0; r < 16; ++r) { p0[r] = nm; p1[r] = nm; } }
            { bf16x8 kf[2 * NDS];
#pragma unroll
              for (int ds = 0; ds < NDS; ++ds) { kf[2 * ds] = *(const LAS bf16x8*)(Kt + rr * KPB + (2 * ds + hi) * 16); kf[2 * ds + 1] = *(const LAS bf16x8*)(Kt + (32 + rr) * KPB + (2 * ds + hi) * 16); }
              __builtin_amdgcn_sched_group_barrier(0x100, 2 * NDS, 0);
#pragma unroll
              for (int ds = 0; ds < NDS; ++ds) {
                p0 = __builtin_amdgcn_mfma_f32_32x32x16_bf16(kf[2 * ds], qf[ds], p0, 0, 0, 0);
                p1 = __builtin_amdgcn_mfma_f32_32x32x16_bf16(kf[2 * ds + 1], qf[ds], p1, 0, 0, 0);
              }
              __builtin_amdgcn_sched_group_barrier(0x008, 2 * NDS, 0); }
            const bool need_mask = (j == 1) || ((VAR == 1 || VAR == 3) && cj == cq);
            const int pk0 = 64 * j + 4 * hi;
            unsigned pw[16];
            bool skip_pv = false;
            if (VAR != 3) {
                if (VAR == 1) {
                    const LAS float* Ft = (const LAS float*)(lds + AT_F0 + buf * AT_FBUF);
#pragma unroll
                    for (int g = 0; g < 4; ++g) { const f32x4 f0 = *(const LAS f32x4*)(Ft + 8 * g + 4 * hi), f1 = *(const LAS f32x4*)(Ft + 32 + 8 * g + 4 * hi);
#pragma unroll
                        for (int k = 0; k < 4; ++k) { p0[4 * g + k] += f0[k]; p1[4 * g + k] += f1[k]; } }
                } else if (VAR == 0) {
                    const float dq = (float)(pq - pk0); const float cap = (j == 1) ? 128.0f : 1e30f;
#pragma unroll
                    for (int r = 0; r < 16; ++r) { const float c0 = (float)(8 * (r >> 2) + (r & 3));
                        p0[r] = fmaf(-slope2, fminf(fabsf(dq - c0), cap), p0[r]); p1[r] = fmaf(-slope2, fminf(fabsf(dq - (c0 + 32.0f)), cap), p1[r]); }
                }
                if (need_mask) {
#pragma unroll
                    for (int r = 0; r < 16; ++r) { const int pk = pk0 + 8 * (r >> 2) + (r & 3);
                        bool v0 = (pk >= PADF), v1 = (pk + 32 >= PADF); if (VAR == 1) { v0 = v0 && (pk <= pq); v1 = v1 && (pk + 32 <= pq); }
                        if (!v0) p0[r] = -1e30f; if (!v1) p1[r] = -1e30f; }
                }
                float mxa = fmaxf(fmaxf(p0[0], p0[1]), p1[0]), mxb = fmaxf(fmaxf(p0[2], p0[3]), p1[1]); mxa = fmaxf(fmaxf(mxa, p1[2]), p1[3]);
#pragma unroll
                for (int r = 4; r < 16; r += 4) { mxa = fmaxf(fmaxf(mxa, p0[r]), p0[r + 1]); mxb = fmaxf(fmaxf(mxb, p0[r + 2]), p0[r + 3]); mxa = fmaxf(fmaxf(mxa, p1[r]), p1[r + 1]); mxb = fmaxf(fmaxf(mxb, p1[r + 2]), p1[r + 3]); }
                const float rm = swap_max(fmaxf(mxa, mxb));
                const bool tile_zero = __all(rm < -200.0f);
                if (!tile_zero) {
                if (__any(rm > ATT_THR)) {
                    const float dl = fmaxf(rm, 0.f); mhat += dl;
#pragma unroll
                    for (int r = 0; r < 16; ++r) { p0[r] -= dl; p1[r] -= dl; }
                    const float f = __builtin_amdgcn_exp2f(-dl); l_run *= f;
#pragma unroll
                    for (int r = 0; r < 16; ++r) { o0[r] *= f; o1[r] *= f; }
                }
                float lsa = 0.f, lsb = 0.f;
#pragma unroll
                for (int r = 0; r < 16; ++r) { p0[r] = __builtin_amdgcn_exp2f(p0[r]); p1[r] = __builtin_amdgcn_exp2f(p1[r]); lsa += p0[r]; lsb += p1[r]; }
                l_run += lsa + lsb;
                }
                skip_pv = tile_zero;
            } else {
                float e0[4], e1[4];
#pragma unroll
                for (int r = 0; r < 16; ++r) {
                    float k0 = __builtin_amdgcn_rcpf(1.0f + __builtin_amdgcn_exp2f(p0[r])), k1 = __builtin_amdgcn_rcpf(1.0f + __builtin_amdgcn_exp2f(p1[r]));
                    if (need_mask) { const int pk = pk0 + 8 * (r >> 2) + (r & 3);
                        if (!((pk >= PADF) && (pk < pq))) k0 = 1.0f; if (!((pk + 32 >= PADF) && (pk + 32 < pq))) k1 = 1.0f; }
                    p0[r] = k0; p1[r] = k1;
                    if ((r & 3) == 0) { e0[r >> 2] = k0; e1[r >> 2] = k1; } else { e0[r >> 2] *= k0; e1[r >> 2] *= k1; }
                }
                float E[8], Od[8];
#pragma unroll
                for (int g = 0; g < 4; ++g) { swap_both(e0[g], E[g], Od[g]); swap_both(e1[g], E[4 + g], Od[4 + g]); }
                float run = R_run, sufE[8], sufO[8];
#pragma unroll
                for (int g = 7; g >= 0; --g) { sufO[g] = run; run *= Od[g]; sufE[g] = run; run *= E[g]; }
                R_run = run; wave_dead = __all(run == 0.f);
#pragma unroll
                for (int g = 0; g < 4; ++g) {
                    float b0 = hi ? sufO[g] : sufE[g], b1 = hi ? sufO[4 + g] : sufE[4 + g];
#pragma unroll
                    for (int k = 3; k >= 0; --k) { const float t0 = p0[4 * g + k] * b0, t1 = p1[4 * g + k] * b1; p0[4 * g + k] = b0 - t0; p1[4 * g + k] = b1 - t1; b0 = t0; b1 = t1; }
                }
            }
            if (!skip_pv) {
#pragma unroll
            for (int r = 0; r < 8; ++r) { pw[r] = cvtpk(p0[2 * r], p0[2 * r + 1]); pw[8 + r] = cvtpk(p1[2 * r], p1[2 * r + 1]); }
            { s16x4 vlo[8], vhi[8];
#pragma unroll
              for (int s = 0; s < 4; ++s)
#pragma unroll
                for (int dh = 0; dh < 2; ++dh) { const LAS unsigned char* vp = Vt + vbase + (2 * s) * 1024 + dh * 512;
                    vlo[2 * s + dh] = __builtin_bit_cast(s16x4, __builtin_amdgcn_ds_read_tr16_b64_v4i16((LAS s16x4*)vp));
                    vhi[2 * s + dh] = __builtin_bit_cast(s16x4, __builtin_amdgcn_ds_read_tr16_b64_v4i16((LAS s16x4*)(vp + 1024))); }
              __builtin_amdgcn_sched_group_barrier(0x100, 16, 0);
#pragma unroll
              for (int s = 0; s < 4; ++s) {
                const u32x4 pf4 = {pw[4 * s], pw[4 * s + 1], pw[4 * s + 2], pw[4 * s + 3]}; const bf16x8 pf = __builtin_bit_cast(bf16x8, pf4);
#pragma unroll
                for (int dh = 0; dh < 2; ++dh) { const s16x4 lo = vlo[2 * s + dh], hh = vhi[2 * s + dh];
                    const bf16x8 vf = {lo[0], lo[1], lo[2], lo[3], hh[0], hh[1], hh[2], hh[3]};
                    if (dh == 0) o0 = __builtin_amdgcn_mfma_f32_32x32x16_bf16(vf, pf, o0, 0, 0, 0); else o1 = __builtin_amdgcn_mfma_f32_32x32x16_bf16(vf, pf, o1, 0, 0, 0);
                }
              }
              __builtin_amdgcn_sched_group_barrier(0x008, 8, 0); }
            }
        }
    };
    for (int i0 = 0; i0 < ntile; i0 += 2) {
        const int base = i0 & 2;
        if (i0 + 2 < ntile) AT_LOAD(a, TILE_OF(i0 + 2));
        if (i0 + 3 < ntile) AT_LOAD(b, TILE_OF(i0 + 3));
        compute_tile(TILE_OF(i0), base);
        if (i0 + 1 < ntile) compute_tile(TILE_OF(i0 + 1), base + 1);
        if (i0 + 2 < ntile) AT_WRITE(a, base ^ 2);
        if (i0 + 3 < ntile) AT_WRITE(b, (base ^ 2) + 1);
        if (VAR == 3) {
            volatile LAS int* fl = (volatile LAS int*)(lds + AT_END) + 8 * ((i0 >> 1) & 1);
            if (lane == 0) fl[wid] = (!wave_on || wave_dead) ? 1 : 0;
            __syncthreads();
            const u32x4 fa = *(const LAS u32x4*)(lds + AT_END + 32 * ((i0 >> 1) & 1)), fb = *(const LAS u32x4*)(lds + AT_END + 32 * ((i0 >> 1) & 1) + 16);
            if (fa.x & fa.y & fa.z & fa.w & fb.x & fb.y & fb.z & fb.w) break; }
        else __syncthreads();
    }
    const float l_tot = swap_sum(l_run);
    if (wave_on) {
        const float inv = (VAR != 3) ? 1.0f / l_tot : 1.0f;
        LAS unsigned char* st = lds + wid * 4608;
#pragma unroll
        for (int g = 0; g < 4; ++g) {
            const u32x2 w0 = {cvtpk(o0[4 * g] * inv, o0[4 * g + 1] * inv), cvtpk(o0[4 * g + 2] * inv, o0[4 * g + 3] * inv)};
            const u32x2 w1 = {cvtpk(o1[4 * g] * inv, o1[4 * g + 1] * inv), cvtpk(o1[4 * g + 2] * inv, o1[4 * g + 3] * inv)};
            *(LAS u32x2*)(st + rr * 144 + 8 * hi + 16 * g) = w0; *(LAS u32x2*)(st + rr * 144 + 64 + 8 * hi + 16 * g) = w1;
        }
        const int sr = lane >> 3, sc = lane & 7;
        bf16_t* ybase = T.y + (rowb + pq0 + sr) * DM + 256 * VAR + 64 * h + 8 * sc;
#pragma unroll
        for (int j = 0; j < 4; ++j) { const u32x4 v = *(const LAS u32x4*)(st + (8 * j + sr) * 144 + 16 * sc); if (pq0 + 8 * j + sr >= PADF) *(u32x4*)(ybase + (size_t)(8 * j) * DM) = v; }
    }
    __syncthreads();
#undef TILE_OF
#undef AT_LOAD
#undef AT_WRITE
}

__device__ __forceinline__ void st4bf(bf16_t* p, float a, float b, float c, float d) { u32x2 w = {cvtpk(a, b), cvtpk(c, d)}; *(u32x2*)p = w; }
__device__ __forceinline__ float sumsq8(bf16x8 v) { float s = 0.f;
#pragma unroll
    for (int i = 0; i < 8; ++i) { const float f = bf2f((bf16_t)v[i]); s += f * f; } return s; }

__device__ __forceinline__ void mla_task(int bi, int qa, int qb, int ka, int kb, const bf16_t* proj, const bf16_t* Wuq, const bf16_t* Wukv, const f32x2* rope, bf16_t* qm, bf16_t* km, bf16_t* vm, int lane, LAS unsigned char* st) {
    const int rr = lane & 31, hi = lane >> 5;
    const int m = bi < NB * 128 ? (bi >> 7) * LSEQ + 128 + 32 * (bi & 127) + rr : (2 * (bi - NB * 128) + (rr >> 4)) * LSEQ + PADF + (rr & 15);
    const int pos = m % LSEQ - PADF;
    const int sr = lane >> 2, sc = lane & 3;
    const int M0 = (bi < NB * 128 ? (bi >> 7) * LSEQ + 128 + 32 * (bi & 127) : (2 * (bi - NB * 128)) * LSEQ + PADF) + sr, M1 = (bi < NB * 128 ? M0 + 16 : M0 + LSEQ);
#define MLA_STORE(dst_, ld_, col_, a_) do { \
        _Pragma("unroll") for (int g = 0; g < 4; ++g) { const u32x2 w_ = {cvtpk(a_[4 * g], a_[4 * g + 1]), cvtpk(a_[4 * g + 2], a_[4 * g + 3])}; *(LAS u32x2*)(st + rr * 80 + 8 * hi + 16 * g) = w_; } \
        const u32x4 v0_ = *(LAS u32x4*)(st + sr * 80 + 16 * sc), v1_ = *(LAS u32x4*)(st + (sr + 16) * 80 + 16 * sc); \
        *(u32x4*)((dst_) + (size_t)M0 * (ld_) + (col_) + 8 * sc) = v0_; *(u32x4*)((dst_) + (size_t)M1 * (ld_) + (col_) + 8 * sc) = v1_; } while (0)
    const bf16_t* prow = proj + (size_t)m * NPROJ;
    const f32x2* rt = rope + (size_t)pos * 16;
    if (qa < qb) {
        bf16x8 cq[16]; float ss = 0.f;
#pragma unroll
        for (int ks = 0; ks < 16; ++ks) { cq[ks] = *(const bf16x8*)(prow + C_CQ + 16 * ks + 8 * hi); ss += sumsq8(cq[ks]); }
        ss = swap_sum(ss); const float rs = __builtin_amdgcn_rsqf(ss * (1.0f / 256.0f) + EPS);
        bf16x8 wa[8], wb[8]; f32x16 acc = {};
#define MLA_LOADQ(dst, nb_, kh_) do { const bf16_t* wf_ = Wuq + (size_t)(nb_) * 8192 + (kh_) * 4096 + lane * 8; _Pragma("unroll") for (int ks = 0; ks < 8; ++ks) dst[ks] = *(const bf16x8*)(wf_ + ks * 512); } while (0)
#define MLA_DOQ(src, nb_, kh_) do { \
            _Pragma("unroll") for (int ks = 0; ks < 8; ++ks) acc = __builtin_amdgcn_mfma_f32_32x32x16_bf16(src[ks], cq[8 * (kh_) + ks], acc, 0, 0, 0); \
            if (kh_) { _Pragma("unroll") for (int r = 0; r < 16; ++r) acc[r] *= rs; \
              const int head = nb_ / 3, part = nb_ - 3 * head; \
              if (part == 2) { _Pragma("unroll") for (int r = 0; r < 8; ++r) { const f32x2 cs = rt[crow(r, hi)]; const float x1 = acc[r], x2 = acc[r + 8]; acc[r] = x1 * cs.x - x2 * cs.y; acc[r + 8] = x1 * cs.y + x2 * cs.x; } } \
              MLA_STORE(qm, 384, 96 * head + 32 * part, acc); \
              acc = (f32x16){}; } } while (0)
        MLA_LOADQ(wa, qa, 0);
#pragma unroll 1
        for (int nb = qa; nb < qb; ++nb) { MLA_LOADQ(wb, nb, 1); MLA_DOQ(wa, nb, 0); if (nb + 1 < qb) MLA_LOADQ(wa, nb + 1, 0); MLA_DOQ(wb, nb, 1); }
#undef MLA_LOADQ
#undef MLA_DOQ
    }
    if (ka < kb) {
        bf16x8 ck[8]; float ss = 0.f;
#pragma unroll
        for (int ks = 0; ks < 8; ++ks) { ck[ks] = *(const bf16x8*)(prow + C_CKV + 16 * ks + 8 * hi); ss += sumsq8(ck[ks]); }
        ss = swap_sum(ss); const float rs = __builtin_amdgcn_rsqf(ss * (1.0f / 128.0f) + EPS);
        bf16x8 wa[8], wb[8];
#define MLA_LOADK(dst, nb_) do { const bf16_t* wf_ = Wukv + (size_t)(nb_) * 4096 + lane * 8; _Pragma("unroll") for (int ks = 0; ks < 8; ++ks) dst[ks] = *(const bf16x8*)(wf_ + ks * 512); } while (0)
#define MLA_DOK(src, nb_) do { f32x16 acc = {}; _Pragma("unroll") for (int ks = 0; ks < 8; ++ks) acc = __builtin_amdgcn_mfma_f32_32x32x16_bf16(src[ks], ck[ks], acc, 0, 0, 0); \
            const int head = (nb_) >> 2, part = (nb_) & 3; \
            _Pragma("unroll") for (int r = 0; r < 16; ++r) acc[r] *= rs; \
            if (part < 2) MLA_STORE(km, 384, 96 * head + 32 * part, acc); else MLA_STORE(vm, 256, 64 * head + 32 * (part - 2), acc); } while (0)
        MLA_LOADK(wa, 2 * ka);
#pragma unroll 1
        for (int kp = ka; kp < kb; ++kp) { const int nb = 2 * kp; MLA_LOADK(wb, nb + 1); MLA_DOK(wa, nb); if (kp + 1 < kb) MLA_LOADK(wa, nb + 2); MLA_DOK(wb, nb + 1); }
#undef MLA_LOADK
#undef MLA_DOK
        if (kb == 8) {
            const bf16x8 x1 = *(const bf16x8*)(prow + C_CKR + 8 * hi), x2 = *(const bf16x8*)(prow + C_CKR + 16 + 8 * hi);
            float o1[8], o2[8];
#pragma unroll
            for (int t = 0; t < 8; ++t) { const f32x2 cs = rt[8 * hi + t]; const float a = bf2f((bf16_t)x1[t]), b = bf2f((bf16_t)x2[t]); o1[t] = a * cs.x - b * cs.y; o2[t] = a * cs.y + b * cs.x; }
            const u32x4 w1 = {cvtpk(o1[0], o1[1]), cvtpk(o1[2], o1[3]), cvtpk(o1[4], o1[5]), cvtpk(o1[6], o1[7])}, w2 = {cvtpk(o2[0], o2[1]), cvtpk(o2[2], o2[3]), cvtpk(o2[4], o2[5]), cvtpk(o2[6], o2[7])};
#pragma unroll
            for (int hd = 0; hd < 4; ++hd) { bf16_t* o = km + (size_t)m * 384 + 96 * hd + 64 + 8 * hi; *(u32x4*)o = w1; *(u32x4*)(o + 16) = w2; }
        }
    }
#undef MLA_STORE
}


template <bool RESID>
__device__ __forceinline__ void meta_side_task(int t, int nN32, const bf16_t* A, const bf16_t* Bt, bf16_t* outb, int ldo, const float* base_meta, int base_bstride, float* hmeta, LAS unsigned char* lds, int lane, int wave) {
    const int blk = t / nN32, nb = t - blk * nN32, rr = lane & 31, hi = lane >> 5;
    const int b = 2 * blk + (rr >> 4), i = rr & 15; const size_t m = (size_t)b * LSEQ + PADF + i;
    const bf16_t* arow = A + (RESID ? m : (size_t)(b * 16 + i)) * DM + 8 * hi + 128 * wave; const bf16_t* wrow = Bt + (size_t)(32 * nb + rr) * DM + 8 * hi + 128 * wave;
    bf16x8 wf[8], af[8];
#pragma unroll
    for (int ks = 0; ks < 8; ++ks) { wf[ks] = *(const bf16x8*)(wrow + 16 * ks); af[ks] = *(const bf16x8*)(arow + 16 * ks); }
    f32x16 acc = {};
#pragma unroll
    for (int ks = 0; ks < 8; ++ks) acc = __builtin_amdgcn_mfma_f32_32x32x16_bf16(wf[ks], af[ks], acc, 0, 0, 0);
    LAS float* part = (LAS float*)lds;
#pragma unroll
    for (int r = 0; r < 16; ++r) part[(wave * 16 + r) * 64 + lane] = acc[r];
    __syncthreads();
#pragma unroll
    for (int q = 0; q < 2; ++q) { const int r = 2 * wave + q; float sum = 0.f;
#pragma unroll
        for (int w = 0; w < 8; ++w) sum += part[(w * 16 + r) * 64 + lane];
        const int n = 32 * nb + crow(r, hi);
        if (!RESID) outb[m * ldo + n] = (bf16_t)(cvtpk(sum * base_meta[NB * SEQ + b * 16 + i], 0.f) & 0xffffu);
        else { const float hv = base_meta[(size_t)(b * base_bstride + i) * DM + n] + sum; hmeta[(size_t)(b * 16 + i) * DM + n] = hv; outb[(size_t)(b * 16 + i) * DM + n] = (bf16_t)(cvtpk(hv, 0.f) & 0xffffu); } }
    __syncthreads();
}

__device__ __forceinline__ void fscan_unit(int b, const bf16_t* proj, const float* bforget, float* negf, LAS unsigned char* lds, int tid) {
    LAS float* part = (LAS float*)lds;
    constexpr int PER = 9;
    float bf[4]; for (int hh = 0; hh < 4; ++hh) bf[hh] = bforget[hh];
    float loc[PER][4]; float s[4] = {0.f, 0.f, 0.f, 0.f};
#pragma unroll
    for (int i = 0; i < PER; ++i) { const int p = tid * PER + i;
        u32x2 w = {0u, 0u}; if (p < LSEQ) w = *(const u32x2*)(proj + ((size_t)b * LSEQ + p) * NPROJ + C_FG);
        const float fg[4] = {bf_lo(w.x), bf_hi(w.x), bf_lo(w.y), bf_hi(w.y)};
#pragma unroll
        for (int hh = 0; hh < 4; ++hh) { const float x = fg[hh] + bf[hh];
            const float ls = fminf(x, 0.f) - __logf(1.0f + __expf(-fabsf(x))); s[hh] += (p >= PADF && p < LSEQ) ? ls : 0.f; loc[i][hh] = s[hh]; } }
    const int ln = tid & 63, wv = tid >> 6; float offs[4];
#pragma unroll
    for (int hh = 0; hh < 4; ++hh) { float inc = s[hh];
#pragma unroll
        for (int d = 1; d < 64; d <<= 1) { const float o = __int_as_float(__builtin_amdgcn_ds_bpermute(4 * (ln - d), __float_as_int(inc))); inc += ln >= d ? o : 0.f; }
        if (ln == 63) part[wv * 4 + hh] = inc;
        offs[hh] = inc - s[hh]; }
    __syncthreads();
#pragma unroll
    for (int hh = 0; hh < 4; ++hh) {
#pragma unroll
        for (int w2 = 0; w2 < 7; ++w2) offs[hh] += w2 < wv ? part[w2 * 4 + hh] : 0.f; }
#pragma unroll
    for (int hh = 0; hh < 4; ++hh) { const float off = offs[hh];
#pragma unroll
        for (int i = 0; i < PER; ++i) { const int p = tid * PER + i; if (p < LSEQ) negf[((size_t)(b * 4 + hh)) * LSEQ + p] = -(off + loc[i][hh]) * LOG2E; } }
    __syncthreads();
}

__device__ __forceinline__ void router_phase(Frame& F, const bf16_t* hb, const bf16_t* Wrt, const float* bgroup, const float* brouter, unsigned* cnt, int* toke, float* tokw, int* tokp, int* elist, float* rsl) {
    const int lane = F.lane, rr = lane & 31, hi = lane >> 5;
    volatile LAS int* hist = F.MISC + 128;
    constexpr int NBLK = HB_ZERO / 32;
    for (int blk0 = 0; blk0 < NBLK; blk0 += F.NGW) {
    const int blk = blk0 + F.wave * F.G + (int)blockIdx.x;
    const bool active = blk < NBLK;
    if (F.tid < 32) hist[F.tid] = 0;
    __syncthreads();
    int e1 = 0, e2 = 0, r1 = 0, r2 = 0; float w1v = 0.f, w2v = 0.f, rs = 0.f; const int hrow = blk * 32 + rr;
    if (active) {
    const bf16_t* xrow = hb + (size_t)hrow * DM + 8 * hi; const bf16_t* w0 = Wrt + lane * 8; const bf16_t* w1 = Wrt + 32768 + (size_t)(rr & 3) * DM + 8 * hi;
    f32x16 a0 = {}, a1 = {}; float ss = 0.f;
#pragma unroll 1
    for (int k8 = 0; k8 < 64; k8 += 8) {
        bf16x8 xb[8], wa[8]; u32x4 wbu[8];
#pragma unroll
        for (int q = 0; q < 8; ++q) { xb[q] = *(const bf16x8*)(xrow + 16 * (k8 + q)); wa[q] = *(const bf16x8*)(w0 + (k8 + q) * 512); wbu[q] = *(const u32x4*)(w1 + 16 * (k8 + q)); }
#pragma unroll
        for (int q = 0; q < 8; ++q) { if (rr >= 4) wbu[q] = (u32x4){0u, 0u, 0u, 0u}; ss += sumsq8(xb[q]);
            a0 = __builtin_amdgcn_mfma_f32_32x32x16_bf16(wa[q], xb[q], a0, 0, 0, 0); a1 = __builtin_amdgcn_mfma_f32_32x32x16_bf16(__builtin_bit_cast(bf16x8, wbu[q]), xb[q], a1, 0, 0, 0); } }
    ss = swap_sum(ss); rs = __builtin_amdgcn_rsqf(ss * (1.0f / DM) + EPS);
    float gl[4];
#pragma unroll
    for (int i = 0; i < 4; ++i) { float lo, hh; swap_both(a1[i], lo, hh); gl[i] = lo * rs + bgroup[i]; }
    int gt = 0; float gmax = gl[0];
#pragma unroll
    for (int i = 1; i < 4; ++i) if (gl[i] > gmax) { gmax = gl[i]; gt = i; }
    float gs = 0.f;
#pragma unroll
    for (int i = 0; i < 4; ++i) gs += __expf(gl[i] - gmax);
    const float gwt = 1.0f / gs;
    float mine[4];
#pragma unroll
    for (int t = 0; t < 4; ++t) mine[t] = (gt == 0) ? a0[t] : (gt == 1) ? a0[4 + t] : (gt == 2) ? a0[8 + t] : a0[12 + t];
    float el[8];
#pragma unroll
    for (int t = 0; t < 4; ++t) { float lo, hh; swap_both(mine[t], lo, hh); el[t] = lo * rs + brouter[8 * gt + t]; el[4 + t] = hh * rs + brouter[8 * gt + 4 + t]; }
    int i1 = 0; float v1 = el[0];
#pragma unroll
    for (int t = 1; t < 8; ++t) if (el[t] > v1) { v1 = el[t]; i1 = t; }
    int i2 = -1; float v2 = -3.0e38f;
#pragma unroll
    for (int t = 0; t < 8; ++t) if (t != i1 && el[t] > v2) { v2 = el[t]; i2 = t; }
    const float ex = __expf(v2 - v1); w1v = gwt / (1.0f + ex); w2v = gwt * ex / (1.0f + ex);
    e1 = 8 * gt + i1; e2 = 8 * gt + i2;
    if (hi == 0) { r1 = __hip_atomic_fetch_add((LAS int*)&hist[e1], 1, __ATOMIC_RELAXED, __HIP_MEMORY_SCOPE_WORKGROUP); r2 = __hip_atomic_fetch_add((LAS int*)&hist[e2], 1, __ATOMIC_RELAXED, __HIP_MEMORY_SCOPE_WORKGROUP); }
    }
    __syncthreads();
    if (F.tid < 32) { const int c = hist[F.tid]; hist[32 + F.tid] = c ? (int)atomicAdd(cnt + F.tid, (unsigned)c) : 0; }
    __syncthreads();
    if (active && hi == 0) { const int p1 = hist[32 + e1] + r1, p2 = hist[32 + e2] + r2;
        int m; if (hrow < HB_META) { const int b = hrow >> 12, t = hrow & (SEQ - 1); m = b * LSEQ + 128 + t; } else { const int q = hrow - HB_META; m = (q >> 4) * LSEQ + PADF + (q & 15); }
        elist[(size_t)e1 * MROWS + p1] = hrow; elist[(size_t)e2 * MROWS + p2] = hrow; rsl[(size_t)e1 * MROWS + p1] = rs; rsl[(size_t)e2 * MROWS + p2] = rs;
        toke[2 * m] = e1; toke[2 * m + 1] = e2; tokw[2 * m] = w1v; tokw[2 * m + 1] = w2v; tokp[2 * m] = p1; tokp[2 * m + 1] = p2; }
    __syncthreads();
    }
}

__device__ __forceinline__ void expert_tiles_to_lds(Frame& F, const unsigned* cnt) {
    if (F.tid < 64) { const int lane = F.tid; const int c = (lane < NEXP) ? (int)cnt[lane] : 0; const int nfull = c >> 8, rem = c & 255; int incl = nfull;
#pragma unroll
        for (int o = 1; o < 32; o <<= 1) { const int v = shfl_up_l(incl, o, lane); if (lane >= o) incl += v; }
        const int nf = __builtin_amdgcn_ds_bpermute(4 * (NEXP - 1), incl);
        int rank = 0, np = 0;
#pragma unroll
        for (int k = 0; k < NEXP; ++k) { const int rk = __builtin_amdgcn_ds_bpermute(4 * k, rem); rank += (rk > rem || (rk == rem && k < lane)) ? 1 : 0; np += rk > 0 ? 1 : 0; }
        if (lane < NEXP) { F.MISC[lane] = incl - nfull; F.MISC[64 + lane] = c; F.MISC[96 + lane] = nf + rank; if (rem > 0) F.MISC[128 + rank] = lane; }
        if (lane == NEXP - 1) { F.MISC[NEXP] = nf; F.MISC[NEXP + 1] = nf + np; } }
    __syncthreads();
}

#define XB_TMO      128
#define XB_XCNT(j)  (256  + 64 * (j))
#define XB_XSUB(j)  (1280 + 64 * (j))
#define XB_XGEN(j)  (2304 + 64 * (j))
#define XB_TOP      3328
#define XB_TOPGEN   3392
#define XCD_BAR_WORDS 3456
#define XB_SPIN_CAP (1u << 20)
__device__ __forceinline__ unsigned xb_ld(unsigned* p)              { return __hip_atomic_load(p, __ATOMIC_RELAXED, __HIP_MEMORY_SCOPE_AGENT); }
__device__ __forceinline__ unsigned xb_add(unsigned* p, unsigned v) { return __hip_atomic_fetch_add(p, v, __ATOMIC_RELAXED, __HIP_MEMORY_SCOPE_AGENT); }
__device__ __forceinline__ unsigned xb_xcc_id() { return (unsigned)__builtin_amdgcn_s_getreg((3 << 11) | 20) & 0xFu; }
#define XB_SPIN(cond, bar) do { unsigned _sp = 0; while (cond) { __builtin_amdgcn_s_sleep(1); \
    if ((++_sp & 255u) == 0u) { if (xb_ld(&(bar)[XB_TMO])) break; if (_sp > XB_SPIN_CAP) { atomicAdd(&(bar)[XB_TMO], 1u); break; } } } } while (0)
struct XcdBarrier { unsigned* bar; unsigned x; volatile LAS unsigned* st; };
__device__ __forceinline__ XcdBarrier xcd_barrier_post(unsigned* bar, volatile LAS unsigned* st) {
    XcdBarrier b; b.bar = bar; b.x = xb_xcc_id(); b.st = st;
    if (threadIdx.x == 0) (void)xb_add(&bar[XB_XCNT(b.x)], 1u);
    return b;
}
__device__ __forceinline__ void xcd_barrier_complete(unsigned* bar, unsigned x, unsigned& nloc, unsigned& nx) {
    const unsigned G = gridDim.x * gridDim.y * gridDim.z;
    unsigned sum, cnt, mine, sp = 0u;
    for (;;) {
        sum = 0u; cnt = 0u; mine = 0u;
#pragma unroll
        for (unsigned j = 0; j < 16; ++j) { const unsigned c = xb_ld(&bar[XB_XCNT(j)]); sum += c; cnt += (c > 0u) ? 1u : 0u; mine = (j == x) ? c : mine; }
        if (sum == G) break;
        __builtin_amdgcn_s_sleep(1);
        if ((++sp & 255u) == 0u) { if (xb_ld(&bar[XB_TMO])) break; if (sp > XB_SPIN_CAP) { atomicAdd(&bar[XB_TMO], 1u); break; } }
    }
    nloc = mine > 0u ? mine : 1u; nx = cnt > 0u ? cnt : 1u;
}
__device__ __forceinline__ void xcd_barrier(const XcdBarrier& b) {
    asm volatile("s_waitcnt vmcnt(0)" ::: "memory");
    __syncthreads();
    if (threadIdx.x == 0) {
        unsigned* bar = b.bar;
        __builtin_amdgcn_s_waitcnt(0);
        unsigned nloc = b.st[0], nx = b.st[1];
        if (nloc == 0u) { xcd_barrier_complete(bar, b.x, nloc, nx); b.st[0] = nloc; b.st[1] = nx; }
        const unsigned old = xb_add(&bar[XB_XSUB(b.x)], 1u);
        const unsigned gen = old / nloc;
        if (old + 1u == (gen + 1u) * nloc) {
            __builtin_amdgcn_fence(__ATOMIC_RELEASE, "agent");
            asm volatile("s_waitcnt vmcnt(0)" ::: "memory");
            const unsigned og = xb_add(&bar[XB_TOP], 1u);
            const unsigned tg = og / nx;
            if (og + 1u == (tg + 1u) * nx) xb_add(&bar[XB_TOPGEN], 1u);
            else XB_SPIN(xb_ld(&bar[XB_TOPGEN]) == tg, bar);
            __builtin_amdgcn_fence(__ATOMIC_ACQUIRE, "agent");
            xb_add(&bar[XB_XGEN(b.x)], 1u);
            asm volatile("s_waitcnt vmcnt(0)" ::: "memory");
        } else {
            XB_SPIN(xb_ld(&bar[XB_XGEN(b.x)]) == gen, bar);
            __builtin_amdgcn_fence(__ATOMIC_ACQUIRE, "agent");
            asm volatile("s_waitcnt vmcnt(0)" ::: "memory");
        }
    }
    __syncthreads();
}

constexpr int N_PHASES = 20;
typedef const __attribute__((address_space(4))) Args* KArgs;
__device__ __forceinline__ KArgs kargs() { auto p = __builtin_amdgcn_kernarg_segment_ptr(); asm volatile("" : "+s"(p)); return (KArgs)p; }
#ifndef PH_MASK
#define PH_MASK 0xFFFFFu
#endif

__global__ void __launch_bounds__(NTHREADS, 2) hymba_fwd(Args args_unused) {
    extern __shared__ __attribute__((aligned(16))) unsigned char lds_raw[];
    Frame F;
    F.lds = (LAS unsigned char*)lds_raw; F.MISC = (volatile LAS int*)(F.lds + MISC_OFF);
    F.tid = threadIdx.x; F.lane = F.tid & 63; F.wave = __builtin_amdgcn_readfirstlane(F.tid >> 6);
    F.G = gridDim.x; F.gw = blockIdx.x * NWAVES + F.wave; F.NGW = F.G * NWAVES;
    int lo, hi_ph; { KArgs A = kargs(); lo = A->ph_lo; hi_ph = A->ph_hi; }
    for (int u = F.tid; u < 64; u += NTHREADS) F.MISC[u] = 0;
    __syncthreads();
#if MK_N_LAUNCHES == 1
    XcdBarrier bar; { KArgs A = kargs(); bar = xcd_barrier_post((unsigned*)(A->ws + WS_CTL) + CW_BAR, (volatile LAS unsigned*)(F.MISC + 48)); }
#endif
#define IN(k) ((((PH_MASK) >> ((k) > 9 ? (k) - 9 : (k))) & 1u) && lo <= (k) && (k) < hi_ph)
#if MK_N_LAUNCHES == 1
#ifndef USE_CG_ALL
#define USE_CG_ALL 0
#endif
#define SEAM_CG() do { if (kargs()->ws == nullptr) cg::this_grid().sync(); xcd_barrier(bar); } while (0)
#define SEAM() do { if (USE_CG_ALL) cg::this_grid().sync(); else xcd_barrier(bar); } while (0)
#else
#define SEAM() do { } while (0)
#define SEAM_CG() do { } while (0)
#endif
#define WSP(T, off) ((T)(ws + (off)))
#ifndef DUP_MASK
#define DUP_MASK 0u
#endif
#define NREP(k, l0) ((((DUP_MASK) >> (k)) & 1u) && (l0) ? 2 : 1)
#define REP_SEAM() do { if (rep > 0) SEAM(); } while (0)
#define PHASE_TID() do { int t_ = threadIdx.x; asm volatile("" : "+v"(t_)); F.tid = t_; F.lane = t_ & 63; F.wave = __builtin_amdgcn_readfirstlane(t_ >> 6); F.gw = blockIdx.x * NWAVES + F.wave; } while (0)

    if (IN(0)) for (int rep = 0; rep < NREP(0, true); ++rep) {
        KArgs A = kargs(); unsigned char* ws = A->ws; PHASE_TID(); REP_SEAM();
        LAS float* scr = (LAS float*)(F.lds + F.wave * 16384);
        constexpr int per_layer = (1024 / 64) * (NPROJ / 32) + (1024 / 64) * (1024 / 32);
        for (int it0 = F.gw; it0 < 2 * per_layer; it0 += F.NGW) {
            const int l = it0 / per_layer, it = it0 - l * per_layer;
            int base = 0; bool done = false;
            unsigned char* wl = ws + WS_W + (size_t)l * W_LAYER;
            transpose_matrix(F, base, it, A->in[3] + (size_t)l * 1024 * 2468, 1024, 2468, NPROJ, A->in[2] + l * DM, (bf16_t*)(wl + W_IN),
                [](int nb, int& sc, int& nv, int& dr) { const int n0 = 32 * nb; dr = n0; if (n0 < 1280) { sc = n0; nv = 32; } else if (n0 < 2464) { sc = n0 + 4; nv = 32; } else if (n0 == 2464) { sc = 1280; nv = 4; } else { sc = 0; nv = 0; } }, scr, done);
            transpose_matrix(F, base, it, A->in[10] + (size_t)l * 1024 * 1024, 1024, 1024, 1024, nullptr, (bf16_t*)(wl + W_OUT),
                [](int nb, int& sc, int& nv, int& dr) { sc = 32 * nb; nv = 32; dr = 32 * nb; }, scr, done);
        }
        for (int i = blockIdx.x * NTHREADS + F.tid; i < 2 * (98304 + 65536 + 32768 + 4096); i += F.G * NTHREADS) {
            const int l = i / (98304 + 65536 + 32768 + 4096); int r = i - l * (98304 + 65536 + 32768 + 4096); unsigned char* wl = ws + WS_W + (size_t)l * W_LAYER;
            if (r < 98304) { const int nb = r >> 13, ks = (r >> 9) & 15, ln = (r >> 3) & 63, j = r & 7, n = 32 * nb + (ln & 31), k = 16 * ks + 8 * (ln >> 5) + j;
                const float v = A->in[8][(size_t)l * 256 * 384 + (size_t)k * 384 + n] * A->in[6][l * 256 + k]; ((bf16_t*)(wl + W_UQ))[r] = (bf16_t)(cvtpk(v, 0.f) & 0xffffu); continue; }
            r -= 98304;
            if (r < 65536) { const int nb = r >> 12, ks = (r >> 9) & 7, ln = (r >> 3) & 63, j = r & 7, n = 32 * nb + (ln & 31), k = 16 * ks + 8 * (ln >> 5) + j;
                const float v = A->in[9][(size_t)l * 128 * 512 + (size_t)k * 512 + n] * A->in[7][l * 128 + k]; ((bf16_t*)(wl + W_UKV))[r] = (bf16_t)(cvtpk(v, 0.f) & 0xffffu); continue; }
            r -= 65536;
            if (r < 32768) { const int ks = r >> 9, ln = (r >> 3) & 63, j = r & 7, n = ln & 31, k = 16 * ks + 8 * (ln >> 5) + j;
                const float v = A->in[14][(size_t)l * 1024 * 32 + (size_t)k * 32 + n] * A->in[11][l * DM + k]; ((bf16_t*)(wl + W_RT))[r] = (bf16_t)(cvtpk(v, 0.f) & 0xffffu); continue; }
            r -= 32768;
            { const int n = r >> 10, k = r & 1023; const float v = A->in[12][(size_t)l * 1024 * 4 + (size_t)k * 4 + n] * A->in[11][l * DM + k]; ((bf16_t*)(wl + W_RT))[32768 + r] = (bf16_t)(cvtpk(v, 0.f) & 0xffffu); }
        }
        if (blockIdx.x == 0 && F.tid < 256) ((u32x2*)(WSP(bf16_t*, WS_HB) + (size_t)HB_ZERO * DM))[F.tid] = (u32x2){0u, 0u};
        f32x2* ROPE = WSP(f32x2*, WS_SMALL + SM_ROPE);
        for (int i = blockIdx.x * NTHREADS + F.tid; i < 4112 * 16; i += F.G * NTHREADS) { const int pos = i >> 4, f = i & 15;
            const float ang = (float)pos * INV_FREQ[f]; float rev = ang * 0.15915494309189535f; rev -= floorf(rev);
            ROPE[i] = (f32x2){__builtin_amdgcn_cosf(rev), __builtin_amdgcn_sinf(rev)}; }
        __syncthreads();
    }

    for (int layer = 0; layer < 2; ++layer) {
        const int P = 1 + 9 * layer;
        if (IN(P + 0)) for (int rep = 0; rep < NREP(1, layer == 0); ++rep) {
            KArgs A = kargs(); unsigned char* ws = A->ws; PHASE_TID(); REP_SEAM();
            if (layer > 0) expert_tiles_to_lds(F, WSP(const unsigned*, WS_CTL) + CW_CNT + 64 * (layer - 1));
            const NormCtx C{A->in[0], A->in[1], A->out, WSP(float*, WS_SMALL + SM_HMETA), WSP(bf16_t*, WS_HB), A->in[2] + layer * DM, WSP(float*, WS_SMALL + SM_RSA), WSP(const bf16_t*, WS_BIG + BIG_XS),
                            WSP(const int*, WS_SMALL + SM_TOKE), WSP(const int*, WS_SMALL + SM_TOKP), WSP(const float*, WS_SMALL + SM_TOKW), F.MISC};
            if (layer == 0) { for (int m0 = 8 * (F.wave * F.G + (int)blockIdx.x); m0 < MROWS; m0 += 8 * F.NGW) norm_rows<0, 8>(C, m0, MROWS, F.lane); }
            else { for (int m0 = 4 * (F.wave * F.G + (int)blockIdx.x); m0 < MROWS; m0 += 4 * F.NGW) norm_rows<1, 4>(C, m0, MROWS, F.lane);
            }
        }
        if (IN(P + 0) && IN(P + 1)) { if (layer == 0) SEAM_CG(); else SEAM(); }
#ifdef EXTRA_BARRIERS
        for (int xb_ = 0; xb_ < EXTRA_BARRIERS; ++xb_) SEAM();
#endif
        if (IN(P + 1)) for (int rep = 0; rep < NREP(2, layer == 0); ++rep) {
            KArgs A = kargs(); unsigned char* ws = A->ws; PHASE_TID(); REP_SEAM(); unsigned char* wl = ws + WS_W + (size_t)layer * W_LAYER;
            pg8::DenseOrder S; S.init(ws + WS_HB, wl + W_IN, DM, DM, MROWS, NPROJ, F.G, (int)blockIdx.x, true);
            pg8::EpiProj E{WSP(bf16_t*, WS_BIG + BIG_PROJ), NPROJ, WSP(const float*, WS_SMALL + SM_RSA)};
            pg8::gemm_phase<false>(F.tid, F.lds, pg8::Gemm{DM, DM, DM}, S, E);
            for (int t = (int)blockIdx.x; t < 4 * (NPROJ / 32); t += F.G)
                meta_side_task<false>(t, NPROJ / 32, WSP(const bf16_t*, WS_HB) + (size_t)HB_META * DM, (const bf16_t*)(wl + W_IN), WSP(bf16_t*, WS_BIG + BIG_PROJ), NPROJ, WSP(const float*, WS_SMALL + SM_RSA), 0, nullptr, F.lds, F.lane, F.wave);
            for (int t = (7 - F.wave) * F.G + (int)blockIdx.x; t < NB * PADF; t += F.NGW) { const int b = t / PADF, p = t - b * PADF; u32x4* o = (u32x4*)(WSP(bf16_t*, WS_BIG + BIG_PROJ) + ((size_t)b * LSEQ + p) * NPROJ) + F.lane;
#pragma unroll
                for (int q = 0; q < NPROJ / 512; ++q) o[64 * q] = (u32x4){0u, 0u, 0u, 0u}; }
        }
        if (IN(P + 1) && IN(P + 2)) SEAM();
        if (IN(P + 2)) for (int rep = 0; rep < NREP(3, layer == 0); ++rep) {
            KArgs A = kargs(); unsigned char* ws = A->ws; PHASE_TID(); REP_SEAM(); unsigned char* wl = ws + WS_W + (size_t)layer * W_LAYER;
            const bf16_t* PROJ = WSP(const bf16_t*, WS_BIG + BIG_PROJ);
            bf16_t* KM = WSP(bf16_t*, WS_BIG + BIG_KM); bf16_t* VM = WSP(bf16_t*, WS_BIG + BIG_VM);
            unsigned zz = 0u; asm volatile("" : "+v"(zz));
            for (int i = (int)blockIdx.x * NTHREADS + F.tid; i < NB * PADF * 80; i += F.G * NTHREADS) { const int r = i / 80, c = i - 80 * r; const size_t mrow = (size_t)(r / PADF) * LSEQ + r % PADF;
                if (c < 48) *(u32x4*)(KM + mrow * 384 + 8 * c) = (u32x4){zz, zz, zz, zz}; else *(u32x4*)(VM + mrow * 256 + 8 * (c - 48)) = (u32x4){zz, zz, zz, zz}; }
            const bool fsc = (int)blockIdx.x >= F.G - NB;
            if (fsc) fscan_unit(F.G - 1 - (int)blockIdx.x, PROJ, A->in[4] + layer * 4, WSP(float*, WS_SMALL + SM_NEGF), F.lds, F.tid);
            constexpr int UNITS = (NB * 128 + NB / 2) * 20, FQ = 6;
            const int nwo = F.NGW - NB * NWAVES, rest = UNITS - FQ * NB * NWAVES, base = rest / nwo, extra = rest - base * nwo;
            int u0, u1;
            if (!fsc) { const int i = F.gw; u0 = base * i + min(i, extra); u1 = u0 + base + (i < extra ? 1 : 0); }
            else { const int j = F.gw - nwo; u0 = rest + FQ * j; u1 = u0 + FQ; }
#pragma unroll 1
            while (u0 < u1) { const int bi = u0 / 20, l0 = u0 - 20 * bi, l1 = min(20, l0 + (u1 - u0));
                mla_task(bi, min(l0, 12), min(l1, 12), max(l0, 12) - 12, max(l1, 12) - 12, PROJ, (const bf16_t*)(wl + W_UQ), (const bf16_t*)(wl + W_UKV), WSP(const f32x2*, WS_SMALL + SM_ROPE), WSP(bf16_t*, WS_BIG + BIG_QM), KM, VM, F.lane, F.lds + 8192 + F.wave * 4096);
                u0 += l1 - l0; }
        }
        if (IN(P + 2) && IN(P + 3)) SEAM();
        if (IN(P + 3)) for (int rep = 0; rep < NREP(4, layer == 0); ++rep) {
            KArgs A = kargs(); unsigned char* ws = A->ws; PHASE_TID(); REP_SEAM();
            const AttnArgs T{WSP(const bf16_t*, WS_BIG + BIG_PROJ), WSP(const bf16_t*, WS_BIG + BIG_QM), WSP(const bf16_t*, WS_BIG + BIG_KM), WSP(const bf16_t*, WS_BIG + BIG_VM), WSP(const float*, WS_SMALL + SM_NEGF), A->in[5] + layer * 4, WSP(bf16_t*, WS_XN)};
            unsigned* qhead = WSP(unsigned*, WS_CTL) + CW_ATTQ + 64 * layer + 16 * rep;
            constexpr int NU_ATT = 16 * 96, NU_MAIN = NU_ATT + XW_WG_ITEMS, NU_A = 512, NU_META = 128, NU = NU_MAIN + NU_A + NU_META;
            static_assert(NU_ATT == 6 * XW_WG_ITEMS, "one conversion item after every 6 attention units");
            for (;;) {
                if (F.tid == 0) F.MISC[40] = (int)atomicAdd(qhead, 1u);
                __syncthreads();
                const int idx = F.MISC[40];
                __syncthreads();
                if (idx >= NU) break;
                if (idx < NU_MAIN && idx % 7 == 6) {
                    xw_wg_item(idx / 7, F.wave, F.lane, A->in[16] + (size_t)layer * NEXP * 1024 * 512, A->in[17] + (size_t)layer * NEXP * 1024 * 512, A->in[18] + (size_t)layer * NEXP * 512 * 1024, A->in[11] + layer * DM,
                               (bf16_t*)(ws + WS_WMOE + WM_GU), (bf16_t*)(ws + WS_WMOE + WM_DN), (LAS float*)(F.lds + F.wave * 16384)); }
                else if (idx < NU_MAIN) { const int ai_ = idx - (idx + 1) / 7; const int u = 15 - ai_ / 96, rem = ai_ % 96, var = rem >> 5, bh = rem & 31, b = bh >> 2, h = bh & 3;
                    if (var == 2) attn_unit<3>(F.tid, T, b, h, u, F.lds); else if (var == 1) attn_unit<1>(F.tid, T, b, h, u, F.lds); else attn_unit<2>(F.tid, T, b, h, u, F.lds);
#ifdef ATT_DUP_VAR
                    if (ATT_DUP_VAR == 3 && var == 2) attn_unit<3>(F.tid, T, b, h, u, F.lds); if (ATT_DUP_VAR == 1 && var == 1) attn_unit<1>(F.tid, T, b, h, u, F.lds); if (ATT_DUP_VAR == 2 && var == 0) attn_unit<2>(F.tid, T, b, h, u, F.lds);
#endif
                    }
                else if (idx < NU_MAIN + NU_A) { const int r = idx - NU_MAIN, u = 15 - (r >> 5), bh = r & 31; attn_unit<0>(F.tid, T, bh >> 2, bh & 3, u, F.lds); }
                else { const int r = idx - NU_MAIN - NU_A, var = r >> 5, bh = r & 31, b = bh >> 2, h = bh & 3;
                    if (var == 0) attn_unit<0>(F.tid, T, b, h, -1, F.lds); else if (var == 1) attn_unit<1>(F.tid, T, b, h, -1, F.lds); else if (var == 2) attn_unit<2>(F.tid, T, b, h, -1, F.lds); else attn_unit<3>(F.tid, T, b, h, -1, F.lds); }
            }
        }
        if (IN(P + 3) && IN(P + 4)) SEAM();
        if (IN(P + 4)) for (int rep = 0; rep < NREP(5, layer == 0); ++rep) {
            KArgs A = kargs(); unsigned char* ws = A->ws; PHASE_TID(); REP_SEAM(); unsigned char* wl = ws + WS_W + (size_t)layer * W_LAYER;
            float* out = A->out; float* HMETA = WSP(float*, WS_SMALL + SM_HMETA);
            pg8::DenseOrder S; S.init(ws + WS_XN, wl + W_OUT, DM, DM, MROWS, DM, F.G, (int)blockIdx.x, false);
            pg8::EpiResid E{WSP(bf16_t*, WS_HB)};
            pg8::gemm_phase<false>(F.tid, F.lds, pg8::Gemm{DM, DM, DM}, S, E);
            for (int t = (int)blockIdx.x; t < 4 * (DM / 32); t += F.G)
                meta_side_task<true>(t, DM / 32, WSP(const bf16_t*, WS_XN), (const bf16_t*)(wl + W_OUT), WSP(bf16_t*, WS_HB) + (size_t)HB_META * DM, 0, layer == 0 ? A->in[1] : HMETA, layer == 0 ? 0 : 16, HMETA, F.lds, F.lane, F.wave);
        }
        if (IN(P + 4) && IN(P + 5)) SEAM();
        if (IN(P + 5)) for (int rep = 0; rep < NREP(6, layer == 0); ++rep) {
            KArgs A = kargs(); unsigned char* ws = A->ws; PHASE_TID(); REP_SEAM(); unsigned char* wl = ws + WS_W + (size_t)layer * W_LAYER;
            router_phase(F, WSP(const bf16_t*, WS_HB), (const bf16_t*)(wl + W_RT), A->in[13] + layer * 4, A->in[15] + layer * 32,
                         WSP(unsigned*, WS_CTL) + CW_CNT + 64 * layer + 32 * rep, WSP(int*, WS_SMALL + SM_TOKE), WSP(float*, WS_SMALL + SM_TOKW), WSP(int*, WS_SMALL + SM_TOKP), WSP(int*, WS_SMALL + SM_ELIST), WSP(float*, WS_SMALL + SM_RSL));
        }
        if (IN(P + 5) && IN(P + 7)) SEAM();
        if (IN(P + 7)) {
            KArgs A = kargs(); unsigned char* ws = A->ws; PHASE_TID(); unsigned char* wl = ws + WS_W + (size_t)layer * W_LAYER;
            expert_tiles_to_lds(F, WSP(const unsigned*, WS_CTL) + CW_CNT + 64 * layer);
            pg8::GroupedOrder S{(const char*)(ws + WS_HB), (const char*)(ws + WS_WMOE + WM_GU), DM, DM, (size_t)1024 * 1024 * 2, F.MISC, F.MISC[NEXP + 1], F.G, (int)blockIdx.x,
                                WSP(const int*, WS_SMALL + SM_ELIST), WSP(const unsigned*, WS_CTL) + CW_CNT + 64 * layer, true, 0, nullptr};
            pg8::EpiSwiGLU E{WSP(bf16_t*, WS_BIG + BIG_HID), EHID, WSP(const float*, WS_SMALL + SM_RSL)};
            pg8::gemm_phase<true>(F.tid, F.lds, pg8::Gemm{DM, DM, DM}, S, E);
        }
        if (IN(P + 7) && IN(P + 8)) SEAM();
        if (IN(P + 8)) {
            KArgs A = kargs(); unsigned char* ws = A->ws; PHASE_TID(); unsigned char* wl = ws + WS_W + (size_t)layer * W_LAYER;
            expert_tiles_to_lds(F, WSP(const unsigned*, WS_CTL) + CW_CNT + 64 * layer);
            unsigned* latecnt = WSP(unsigned*, WS_CTL) + CW_LATE + 16 * layer;
            { pg8::GroupedOrder S{(const char*)(ws + WS_HB), (const char*)(ws + WS_WMOE + WM_GU), DM, DM, (size_t)1024 * 1024 * 2, F.MISC, F.MISC[NEXP + 1], F.G, (int)blockIdx.x,
                                  WSP(const int*, WS_SMALL + SM_ELIST), WSP(const unsigned*, WS_CTL) + CW_CNT + 64 * layer, true, 1, nullptr};
              pg8::Unit probe;
              if (S.next(0, probe)) {
                  pg8::EpiSwiGLU E{WSP(bf16_t*, WS_BIG + BIG_HID), EHID, WSP(const float*, WS_SMALL + SM_RSL)};
                  pg8::gemm_phase<true>(F.tid, F.lds, pg8::Gemm{DM, DM, DM}, S, E);
                  asm volatile("s_waitcnt vmcnt(0)" ::: "memory"); __syncthreads();
                  if (F.tid == 0) { __builtin_amdgcn_fence(__ATOMIC_RELEASE, "agent"); asm volatile("s_waitcnt vmcnt(0)" ::: "memory"); __hip_atomic_fetch_add(latecnt, 1u, __ATOMIC_RELAXED, __HIP_MEMORY_SCOPE_AGENT); }
                  __syncthreads(); } }
            { KArgs A2 = kargs(); unsigned char* ws2 = A2->ws; PHASE_TID();
              pg8::GroupedOrder S{(const char*)(ws2 + WS_BIG + BIG_HID), (const char*)(ws2 + WS_WMOE + WM_DN), EHID, EHID, (size_t)1024 * 512 * 2, F.MISC, F.MISC[NEXP + 1], F.G, (int)blockIdx.x, nullptr, nullptr, false, 2, latecnt};
              pg8::EpiBf16 E{(bf16_t*)(ws2 + WS_BIG + BIG_XS), DM};
              pg8::gemm_phase<false>(F.tid, F.lds, pg8::Gemm{EHID, EHID, EHID}, S, E); }
        }
        if (IN(P + 8) && IN(P + 9)) SEAM();
    }
    if (IN(19)) {
        KArgs A = kargs(); unsigned char* ws = A->ws; PHASE_TID();
        expert_tiles_to_lds(F, WSP(const unsigned*, WS_CTL) + CW_CNT + 64);
        const NormCtx C{nullptr, nullptr, A->out, nullptr, WSP(bf16_t*, WS_HB), A->in[19], nullptr, WSP(const bf16_t*, WS_BIG + BIG_XS), WSP(const int*, WS_SMALL + SM_TOKE), WSP(const int*, WS_SMALL + SM_TOKP), WSP(const float*, WS_SMALL + SM_TOKW), F.MISC};
        for (int m0 = 4 * (F.wave * F.G + (int)blockIdx.x); m0 < NB * SEQ; m0 += 4 * F.NGW) norm_rows<2, 4>(C, m0, NB * SEQ, F.lane);
    }
#undef IN
#undef SEAM
#undef SEAM_CG
#undef WSP
}

extern "C" void kernel_launch(void* const* d_in, const int* in_sizes, int n_in, void* d_out, int out_size, void* d_ws, size_t ws_size, hipStream_t stream) {
    static int grid = 0;
    if (grid == 0) {
        if (n_in != 20 || out_size != NB * SEQ * DM || ws_size < WS_END) { fprintf(stderr, "kernel_launch: unexpected shapes (n_in %d, out %d, ws %zu < %zu)\n", n_in, out_size, ws_size, (size_t)WS_END); grid = -1; return; }
        int dev = 0, cus = 0, per_cu = 0;
        hipGetDevice(&dev); hipDeviceGetAttribute(&cus, hipDeviceAttributeMultiprocessorCount, dev);
        if (hipFuncSetAttribute((const void*)hymba_fwd, hipFuncAttributeMaxDynamicSharedMemorySize, LDS_BYTES) != hipSuccess) { fprintf(stderr, "kernel_launch: hipFuncSetAttribute failed\n"); grid = -1; return; }
        if (hipOccupancyMaxActiveBlocksPerMultiprocessor(&per_cu, (const void*)hymba_fwd, NTHREADS, LDS_BYTES) != hipSuccess || per_cu < 1) { fprintf(stderr, "kernel_launch: occupancy query failed (%d)\n", per_cu); per_cu = 1; }
        (void)hipGetLastError();
        grid = cus;
    }
    if (grid < 0) return;
    hipMemsetAsync((char*)d_ws + WS_CTL, 0, CTL_BYTES, stream);
    Args a{};
    for (int i = 0; i < 20; ++i) a.in[i] = (const float*)d_in[i];
    a.out = (float*)d_out; a.ws = (unsigned char*)d_ws;
#if MK_N_LAUNCHES == 1
    a.ph_lo = 0; a.ph_hi = N_PHASES;
    void* kargs[] = {&a};
    hipError_t e = hipLaunchCooperativeKernel((const void*)hymba_fwd, dim3(grid), dim3(NTHREADS), kargs, LDS_BYTES, stream);
    if (e != hipSuccess) fprintf(stderr, "cooperative launch failed: %s (grid %d)\n", hipGetErrorString(e), grid);
#else
    for (int ph = 0; ph < N_PHASES; ++ph) { a.ph_lo = ph; a.ph_hi = ph + 1; hipLaunchKernelGGL(hymba_fwd, dim3(grid), dim3(NTHREADS), LDS_BYTES, stream, a); }
#endif
}
```

```cpp
#include <hip/hip_runtime.h>
#include <hip/hip_cooperative_groups.h>
#include <cstdio>
#include <cstdint>
namespace cg = cooperative_groups;

#ifndef MK_N_LAUNCHES
#define MK_N_LAUNCHES 1
#endif

constexpr int NB = 8, SEQ = 4096, DM = 1024, LSEQ = SEQ + 128, MROWS = NB * LSEQ;
constexpr int PADF = 112;
constexpr int NPROJ = 2560;
constexpr int C_AQ = 0, C_AK = 256, C_AV = 384, C_FQ = 512, C_FK = 768, C_FV = 1024, C_CQ = 1280, C_CKV = 1536, C_CKR = 1664, C_SQ = 1696, C_SK = 1952, C_SV = 2208, C_FG = 2464;
constexpr int NEXP = 32, EHID = 512;
constexpr float EPS = 1e-6f;
constexpr float LOG2E = 1.4426950408889634f;
constexpr int NWAVES = 8, NTHREADS = 512;
constexpr int HB_META = NB * SEQ, HB_ZERO = NB * SEQ + NB * 16, HB_ROWS = HB_ZERO + 1;
constexpr int PMAX_ROWS = 74240;

constexpr size_t MiB = 1u << 20;
constexpr size_t WS_CTL = 0, CTL_BYTES = 1 * MiB;
constexpr size_t W_IN = 0, W_OUT = W_IN + (size_t)NPROJ * DM * 2, W_UQ = W_OUT + (size_t)DM * DM * 2, W_UKV = W_UQ + 384 * 256 * 2, W_RT = W_UKV + 512 * 128 * 2, W_LAYER = W_RT + 64 * 1024 * 2;
constexpr size_t WM_GU = 0, WM_DN = WM_GU + (size_t)NEXP * 1024 * 1024 * 2, WM_END = WM_DN + (size_t)NEXP * 1024 * 512 * 2;
constexpr size_t WS_W = 1 * MiB;
constexpr size_t WS_WMOE = 17 * MiB;
constexpr size_t WS_HB = 114 * MiB;
constexpr size_t WS_XN = 179 * MiB;
constexpr size_t WS_BIG = 246 * MiB;
constexpr size_t BIG_PROJ = 0, BIG_QM = (size_t)MROWS * NPROJ * 2, BIG_KM = BIG_QM + (size_t)MROWS * 384 * 2, BIG_VM = BIG_KM + (size_t)MROWS * 384 * 2, BIG_ATT_END = BIG_VM + (size_t)MROWS * 256 * 2;
constexpr size_t BIG_XS = 0, BIG_HID = (size_t)PMAX_ROWS * 1024 * 2, BIG_MOE_END = BIG_HID + (size_t)PMAX_ROWS * 512 * 2;
constexpr size_t WS_SMALL = 478 * MiB;
constexpr size_t SM_NEGF = 0, SM_ROPE = SM_NEGF + (size_t)NB * 4 * LSEQ * 4, SM_TOKE = SM_ROPE + (size_t)4112 * 16 * 8, SM_TOKW = SM_TOKE + (size_t)MROWS * 8, SM_TOKP = SM_TOKW + (size_t)MROWS * 8,
                 SM_HMETA = SM_TOKP + (size_t)MROWS * 8, SM_ELIST = SM_HMETA + (size_t)NB * 16 * DM * 4, SM_RSL = SM_ELIST + (size_t)NEXP * MROWS * 4, SM_RSA = SM_RSL + (size_t)NEXP * MROWS * 4, SM_END = SM_RSA + (size_t)(NB * SEQ + NB * 16) * 4;
constexpr size_t WS_END = WS_SMALL + 12 * MiB;
static_assert(WS_W + 2 * W_LAYER <= WS_WMOE && WS_WMOE + WM_END <= WS_HB && WS_HB + (size_t)HB_ROWS * DM * 2 <= WS_XN, "weights / residual regions");
static_assert(WS_XN + (size_t)MROWS * DM * 2 <= WS_BIG, "xn region");
static_assert(WS_BIG + BIG_ATT_END <= WS_SMALL && WS_BIG + BIG_MOE_END <= WS_SMALL, "big region");
static_assert(SM_END <= 12 * MiB, "small region");
constexpr int CW_ATTQ = 64;
constexpr int CW_CNT = 256;
constexpr int CW_LATE = 512;
constexpr int CW_BAR = 4096;

constexpr int RING_BYTES = 131072;
constexpr int MISC_OFF = RING_BYTES;
constexpr int LDS_BYTES = 147456;

#define GAS __attribute__((address_space(1)))
#define LAS __attribute__((address_space(3)))
typedef unsigned short bf16_t;
typedef short bf16x8 __attribute__((ext_vector_type(8)));
typedef short s16x4 __attribute__((ext_vector_type(4)));
typedef float f32x4 __attribute__((ext_vector_type(4)));
typedef float f32x2 __attribute__((ext_vector_type(2)));
typedef float f32x16 __attribute__((ext_vector_type(16)));
typedef unsigned u32x4 __attribute__((ext_vector_type(4)));
typedef unsigned u32x2 __attribute__((ext_vector_type(2)));
typedef __bf16 bf16x2_t __attribute__((ext_vector_type(2)));

__device__ __forceinline__ unsigned cvtpk(float lo, float hi) { f32x2 v = {lo, hi}; bf16x2_t b = __builtin_convertvector(v, bf16x2_t); return __builtin_bit_cast(unsigned, b); }
__device__ __forceinline__ float bf_lo(unsigned w) { return __uint_as_float(w << 16); }
__device__ __forceinline__ float bf_hi(unsigned w) { return __uint_as_float(w & 0xffff0000u); }
__device__ __forceinline__ float bf2f(bf16_t v) { return __uint_as_float((unsigned)v << 16); }
__device__ __forceinline__ float shfl_xor_l(float v, int o, int lane) { return __int_as_float(__builtin_amdgcn_ds_bpermute(4 * (lane ^ o), __float_as_int(v))); }
__device__ __forceinline__ int shfl_up_l(int v, int o, int lane) { return __builtin_amdgcn_ds_bpermute(4 * (lane - o), v); }
__device__ __forceinline__ float swap_sum(float v) { auto rr = __builtin_amdgcn_permlane32_swap(__float_as_uint(v), __float_as_uint(v), false, false); return __uint_as_float(rr[0]) + __uint_as_float(rr[1]); }
__device__ __forceinline__ float swap_max(float v) { auto rr = __builtin_amdgcn_permlane32_swap(__float_as_uint(v), __float_as_uint(v), false, false); return fmaxf(__uint_as_float(rr[0]), __uint_as_float(rr[1])); }
__device__ __forceinline__ void swap_both(float v, float& from_lo, float& from_hi) { auto rr = __builtin_amdgcn_permlane32_swap(__float_as_uint(v), __float_as_uint(v), false, false); from_lo = __uint_as_float(rr[0]); from_hi = __uint_as_float(rr[1]); }
__device__ __forceinline__ int crow(int r, int hi) { return (r & 3) + 8 * (r >> 2) + 4 * hi; }

namespace pg8 {
constexpr int BM = 256, BK = 64, HALF = 128, HTB = HALF * BK * 2, STAGE_BYTES = 8 * HTB;
__host__ __device__ __forceinline__ int lds_byte(int r, int c) { const int st = (r >> 4) * 2 + (c >> 5), rr = r & 15, cc = c & 31, ob = rr * 64 + cc * 2; return st * 1024 + (ob ^ (((ob >> 9) & 1) << 5)); }
__host__ __device__ __forceinline__ void stage_rc(int b, int& R, int& C) { const int st = b / 1024, sb = b % 1024, swz = sb ^ (((sb >> 9) & 1) << 5); R = (st >> 1) * 16 + swz / 64; C = (st & 1) * 32 + (swz % 64) / 2; }
__host__ __device__ __forceinline__ int perm32(int rho) { const int n = rho >> 4, i = rho & 15; return 8 * (i >> 2) + 4 * n + (i & 3); }

struct Unit { const char* a; const char* b; int pm, pn; int e, r0; int row0; int nv; int late; };
struct Gemm { int lda, ldb, K; };

struct DenseOrder {
    static constexpr bool GATHER_CAPABLE = false; static constexpr bool PARTIAL = false;
    __device__ __forceinline__ void acquire_late(int) const {}
    __device__ __forceinline__ unsigned row_off(const Unit&, int) const { return 0u; }
    __device__ __forceinline__ void row_off4(const Unit&, const int (&)[4], unsigned (&off)[4]) const { off[0] = off[1] = off[2] = off[3] = 0u; }
    const char* A; const char* Bt; int lda, ldb; int nM, nN, nwg, G, c; bool areal;
    __device__ void init(const void* A_, const void* Bt_, int lda_, int ldb_, int M, int N, int G_, int c_, bool areal_) { areal = areal_; A = (const char*)A_; Bt = (const char*)Bt_; lda = lda_; ldb = ldb_; nM = NB * (SEQ / BM); (void)M; nN = N / BM; nwg = nM * nN; G = G_; c = c_; }
    __device__ bool next(int i, Unit& u) const {
        const long L = (long)i * G + c; if (L >= nwg) return false;
        int wgid = (int)L; { const int q = nwg / 8, r = nwg % 8, xcd = wgid % 8, off = wgid / 8; wgid = (xcd < r ? xcd * (q + 1) : r * (q + 1) + (xcd - r) * q) + off; }
        const int nig = 8 * nN, gid = wgid / nig, fm = gid * 8, gsz = (nM - fm) < 8 ? (nM - fm) : 8;
        u.pm = fm + ((wgid % nig) % gsz); u.pn = (wgid % nig) / gsz;
        u.e = 0; u.r0 = 0; u.nv = BM; u.late = 0; u.row0 = (u.pm >> 4) * LSEQ + 128 + ((u.pm & 15) << 8);
        u.a = A + (size_t)(areal ? u.pm * BM : u.row0) * lda * 2; u.b = Bt + (size_t)u.pn * BM * ldb * 2; return true;
    }
};
struct GroupedOrder {
    static constexpr bool GATHER_CAPABLE = true; static constexpr bool PARTIAL = true;
    const char* A; const char* Bt; int lda, ldb; size_t bstride; const volatile LAS int* tstart; int ntile, G, c; const int* elist; const unsigned* cnt; bool gather;
    __device__ __forceinline__ void row_off4(const Unit& u, const int (&r)[4], unsigned (&off)[4]) const { const int n = tstart[64 + u.e]; int tok[4];
#pragma unroll
        for (int k = 0; k < 4; ++k) { const int i = u.r0 + r[k]; tok[k] = elist[(size_t)u.e * MROWS + (i < n ? i : 0)]; }
#pragma unroll
        for (int k = 0; k < 4; ++k) off[k] = (unsigned)((u.r0 + r[k] < n) ? tok[k] : HB_ZERO) * (unsigned)(lda * 2); }
    __device__ __forceinline__ unsigned row_off(const Unit& u, int r) const { const int i = u.r0 + r; const int n = tstart[64 + u.e];
        const int tok = elist[(size_t)u.e * MROWS + (i < n ? i : 0)]; return (i < n) ? (unsigned)tok * (unsigned)(lda * 2) : 0u; }
    int mode; const unsigned* latecnt;
    __device__ __forceinline__ void acquire_late(int tid) const {
        if (tid == 0) { const int total = ntile * 4, L = total - (total / G) * G;
            while (__hip_atomic_load(latecnt, __ATOMIC_RELAXED, __HIP_MEMORY_SCOPE_AGENT) < (unsigned)L) __builtin_amdgcn_s_sleep(8);
            __builtin_amdgcn_fence(__ATOMIC_ACQUIRE, "agent"); asm volatile("s_waitcnt vmcnt(0)" ::: "memory"); } }
    __device__ __forceinline__ void fill(int idx, Unit& u) const {
        const int tile = idx >> 2, pn = idx & 3, nf = tstart[NEXP]; int e = 0;
        if (tile < nf) { for (int k = 1; k < NEXP; ++k) e += (tstart[k] <= tile) ? 1 : 0; u.r0 = (tile - tstart[e]) * BM; u.nv = BM; }
        else { e = tstart[128 + tile - nf]; u.r0 = (tstart[e + 1] - tstart[e]) * BM; u.nv = tstart[64 + e] & (BM - 1); }
        u.pm = tile; u.pn = pn; u.e = e; u.late = 0; u.row0 = tile * BM; u.a = gather ? A : A + (size_t)tile * BM * lda * 2; u.b = Bt + (size_t)e * bstride + (size_t)pn * BM * ldb * 2;
    }
    __device__ __forceinline__ bool next(int i, Unit& u) const {
        const int v0 = (G % 8 == 0) ? (c % 8) * (G / 8) + c / 8 : c;
        const int total = ntile * 4, R = total / G, L = total - R * G;
        if (mode == 0) { if (i >= R) return false; fill(i * G + ((i & 1) ? G - 1 - v0 : v0), u); return true; }
        if (mode == 1) { if (i > 0 || v0 >= L) return false; fill(R * G + v0, u); return true; }
        const bool late = v0 < L; const int slot = late ? G - L + v0 : v0 - L, NN = R * G;
        auto normal = [&](int t) -> int { const int r = late ? t + 2 : t; const int w = (r < 2) ? G - L : G, off = (r < 2) ? r * (G - L) : 2 * (G - L) + (r - 2) * G; const int n = off + slot; return (slot < w && n < NN) ? n : -1; };
        const int n = normal(i);
        if (n >= 0) { fill(n, u); return true; }
        if (late && (i == 0 || normal(i - 1) >= 0)) { fill(NN + v0, u); u.late = 1; return true; }
        return false;
    }
};

struct EpiBf16 {
    static constexpr bool PERM = true;
    bf16_t* O; int ldc;
    __device__ __forceinline__ void operator()(const f32x4 (&acc)[2][2][4][2], const Unit& u, int wr, int wc, int fr, int fq) const {
        const int row0 = u.row0 + wr * 64 + fr, col0 = u.pn * BM + wc * 32 + 8 * fq;
#pragma unroll
        for (int ai = 0; ai < 2; ++ai) { if (u.nv <= ai * HALF + wr * 64) continue;
#pragma unroll
            for (int m = 0; m < 4; ++m) { bf16_t* rowp = O + (size_t)(row0 + ai * HALF + m * 16) * ldc + col0;
#pragma unroll
                for (int bj = 0; bj < 2; ++bj) { const f32x4 v0 = acc[ai][bj][m][0], v1 = acc[ai][bj][m][1];
                    u32x4 w; w.x = cvtpk(v0[0], v0[1]); w.y = cvtpk(v0[2], v0[3]); w.z = cvtpk(v1[0], v1[1]); w.w = cvtpk(v1[2], v1[3]);
                    *(u32x4*)(rowp + bj * HALF) = w; } } }
    }
};
struct EpiProj {
    static constexpr bool PERM = true;
    bf16_t* O; int ldc; const float* rsa;
    __device__ __forceinline__ void operator()(const f32x4 (&acc)[2][2][4][2], const Unit& u, int wr, int wc, int fr, int fq) const {
        const int row0 = u.row0 + wr * 64 + fr, col0 = u.pn * BM + wc * 32 + 8 * fq;
        float rsv[2][4];
#pragma unroll
        for (int ai = 0; ai < 2; ++ai)
#pragma unroll
            for (int m = 0; m < 4; ++m) rsv[ai][m] = rsa[u.pm * BM + wr * 64 + fr + ai * HALF + m * 16];
        __builtin_amdgcn_sched_barrier(0);
#pragma unroll
        for (int ai = 0; ai < 2; ++ai)
#pragma unroll
            for (int m = 0; m < 4; ++m) { bf16_t* rowp = O + (size_t)(row0 + ai * HALF + m * 16) * ldc + col0; const float rs = rsv[ai][m];
#pragma unroll
                for (int bj = 0; bj < 2; ++bj) { const f32x4 v0 = acc[ai][bj][m][0], v1 = acc[ai][bj][m][1];
                    u32x4 w; w.x = cvtpk(v0[0] * rs, v0[1] * rs); w.y = cvtpk(v0[2] * rs, v0[3] * rs); w.z = cvtpk(v1[0] * rs, v1[1] * rs); w.w = cvtpk(v1[2] * rs, v1[3] * rs);
                    *(u32x4*)(rowp + bj * HALF) = w; } }
    }
};
struct EpiSwiGLU {
    static constexpr bool PERM = true;
    bf16_t* H; int ldc; const float* rsl;
    __device__ __forceinline__ void operator()(const f32x4 (&acc)[2][2][4][2], const Unit& u, int wr, int wc, int fr, int fq) const {
        const int row0 = u.row0 + wr * 64 + fr, col0 = u.pn * HALF + wc * 32 + 8 * fq;
        float rsv[2][4];
#pragma unroll
        for (int ai = 0; ai < 2; ++ai)
#pragma unroll
            for (int m = 0; m < 4; ++m) rsv[ai][m] = rsl[(size_t)u.e * MROWS + u.r0 + wr * 64 + fr + ai * HALF + m * 16];
        __builtin_amdgcn_sched_barrier(0);
#pragma unroll
        for (int ai = 0; ai < 2; ++ai) { if (u.nv <= ai * HALF + wr * 64) continue;
#pragma unroll
            for (int m = 0; m < 4; ++m) { bf16_t* rowp = H + (size_t)(row0 + ai * HALF + m * 16) * ldc + col0; float o[8];
#pragma unroll
                for (int n = 0; n < 2; ++n)
#pragma unroll
                    for (int k = 0; k < 4; ++k) { const float g = acc[ai][0][m][n][k] * rsv[ai][m], up = acc[ai][1][m][n][k] * rsv[ai][m]; o[n * 4 + k] = g * __builtin_amdgcn_rcpf(1.0f + __builtin_amdgcn_exp2f(-g * LOG2E)) * up; }
                u32x4 w; w.x = cvtpk(o[0], o[1]); w.y = cvtpk(o[2], o[3]); w.z = cvtpk(o[4], o[5]); w.w = cvtpk(o[6], o[7]);
                *(u32x4*)rowp = w; } }
    }
};
struct EpiResid {
    static constexpr bool PERM = true;
    bf16_t* out;
    __device__ __forceinline__ void operator()(const f32x4 (&acc)[2][2][4][2], const Unit& u, int wr, int wc, int fr, int fq) const {
        const int col0 = u.pn * BM + wc * 32 + 8 * fq;
        bf16_t* o0 = out + (size_t)(u.pm * BM + wr * 64 + fr) * DM + col0;
        u32x4 w[2][4][2];
#pragma unroll
        for (int ai = 0; ai < 2; ++ai)
#pragma unroll
            for (int m = 0; m < 4; ++m)
#pragma unroll
                for (int bj = 0; bj < 2; ++bj) w[ai][m][bj] = *(const u32x4*)(o0 + (size_t)(ai * HALF + m * 16) * DM + bj * HALF);
        __builtin_amdgcn_sched_barrier(0);
#pragma unroll
        for (int ai = 0; ai < 2; ++ai)
#pragma unroll
            for (int m = 0; m < 4; ++m)
#pragma unroll
                for (int bj = 0; bj < 2; ++bj) { const u32x4 b = w[ai][m][bj];
                    const f32x4 v0 = acc[ai][bj][m][0] + (f32x4){bf_lo(b.x), bf_hi(b.x), bf_lo(b.y), bf_hi(b.y)}, v1 = acc[ai][bj][m][1] + (f32x4){bf_lo(b.z), bf_hi(b.z), bf_lo(b.w), bf_hi(b.w)};
                    u32x4 o; o.x = cvtpk(v0[0], v0[1]); o.y = cvtpk(v0[2], v0[3]); o.z = cvtpk(v1[0], v1[1]); o.w = cvtpk(v1[2], v1[3]);
                    *(u32x4*)(o0 + (size_t)(ai * HALF + m * 16) * DM + bj * HALF) = o; }
    }
};

template <bool GATHER, class Epi, class Sched>
__device__ __forceinline__ void gemm_phase(int tid, LAS unsigned char* lds, const Gemm g, const Sched& S, const Epi& E) {
    const int wid = __builtin_amdgcn_readfirstlane(tid >> 6), lane = tid & 63, wr = wid >> 2, wc = wid & 3, fr = lane & 15, fq = lane >> 4;
    const int K = g.K, nt = K / BK;
    unsigned voffA0[2], voffA1[2], nA0[2], nA1[2], voffB[2];
    const size_t hstepB = (size_t)HALF * g.ldb * 2;
#pragma unroll
    for (int i = 0; i < 2; ++i) { int R, C; stage_rc(tid * 16 + i * 8192, R, C); const int Rb = Epi::PERM ? ((R & ~31) + perm32(R & 31)) : R;
        voffA0[i] = (unsigned)(R * g.lda + C) * 2u; voffA1[i] = voffA0[i] + (unsigned)(HALF * g.lda * 2); nA0[i] = voffA0[i]; nA1[i] = voffA1[i]; voffB[i] = (unsigned)(Rb * g.ldb + C) * 2u; }
    const size_t kstep = (size_t)(BK * 2);
    const unsigned ldsw = (unsigned)wid * 1024u;
    const int aoff = lds_byte(wr * 64 + fr, fq * 8), boff = lds_byte(wc * 32 + fr, fq * 8);
#define PG8_SA(b, h) (((b) * 2 + (h)) * HTB)
#define PG8_SB(b, h) ((4 + (b) * 2 + (h)) * HTB)
#define PG8_STAGE(bufoff, gbase, voff) do { _Pragma("unroll") for (int _i = 0; _i < 2; ++_i) \
        __builtin_amdgcn_global_load_lds((const unsigned*)((const char*)(gbase) + (voff)[_i]), (LAS unsigned*)(lds + (bufoff) + ldsw + _i * 8192), 16, 0, 0); } while (0)
#define PG8_LDA(dst, b, h) do { _Pragma("unroll") for (int m = 0; m < 4; ++m) _Pragma("unroll") for (int k = 0; k < 2; ++k) dst[m][k] = *(const LAS bf16x8*)(lds + PG8_SA(b, h) + aoff + m * 2048 + k * 1024); } while (0)
#define PG8_LDB(dst, b, h) do { _Pragma("unroll") for (int n = 0; n < 2; ++n) _Pragma("unroll") for (int k = 0; k < 2; ++k) dst[n][k] = *(const LAS bf16x8*)(lds + PG8_SB(b, h) + boff + n * 2048 + k * 1024); } while (0)
#define PG8_MMA(ai, bj, At, Bt) do { __builtin_amdgcn_s_setprio(1); _Pragma("unroll") for (int m = 0; m < 4; ++m) _Pragma("unroll") for (int n = 0; n < 2; ++n) _Pragma("unroll") for (int k = 0; k < 2; ++k) \
        acc[ai][bj][m][n] = __builtin_amdgcn_mfma_f32_16x16x32_bf16(Bt[n][k], At[m][k], acc[ai][bj][m][n], 0, 0, 0); __builtin_amdgcn_s_setprio(0); } while (0)
#define PG8_WAIT_V(n) asm volatile("s_waitcnt vmcnt(" #n ")" ::: "memory")
#define PG8_WAIT_V8_UNLESS(c) asm volatile("s_cmp_lg_u32 %0, 0\n\ts_cbranch_scc1 1f\n\ts_waitcnt vmcnt(8)\n1:" :: "s"(c) : "memory", "scc")
#define PG8_WAIT_L(n) asm volatile("s_waitcnt lgkmcnt(" #n ")" ::: "memory")
#define PG8_BAR __builtin_amdgcn_s_barrier()
#define PG8_SCHED __builtin_amdgcn_sched_barrier(0)
    Unit cur, nxt; int ui = 0;
    if (!S.next(0, cur)) return;
    if (Sched::PARTIAL && cur.late) { S.acquire_late(tid); __syncthreads(); }
    f32x4 acc[2][2][4][2];
#pragma unroll
    for (int a = 0; a < 2; ++a)
#pragma unroll
        for (int b = 0; b < 2; ++b)
#pragma unroll
            for (int m = 0; m < 4; ++m)
#pragma unroll
                for (int n = 0; n < 2; ++n) acc[a][b][m][n] = (f32x4){0.f, 0.f, 0.f, 0.f};
    bf16x8 At[4][2], B0[2][2], B1[2][2];
    const char* cA = cur.a; const char* cB = cur.b;
    if (GATHER) { int RA[2], CA[2]; { int tl_ = tid; asm volatile("" : "+v"(tl_)); stage_rc(tl_ * 16, RA[0], CA[0]); stage_rc(tl_ * 16 + 8192, RA[1], CA[1]); }     const int r4[4] = {RA[0], RA[1], HALF + RA[0], HALF + RA[1]}; unsigned o4[4]; S.row_off4(cur, r4, o4);
        voffA0[0] = o4[0] + (unsigned)(CA[0] * 2); voffA0[1] = o4[1] + (unsigned)(CA[1] * 2); voffA1[0] = o4[2] + (unsigned)(CA[0] * 2); voffA1[1] = o4[3] + (unsigned)(CA[1] * 2); }
    PG8_STAGE(PG8_SB(0, 0), cB, voffB); PG8_STAGE(PG8_SB(0, 1), cB + hstepB, voffB); PG8_STAGE(PG8_SA(0, 0), cA, voffA0); PG8_STAGE(PG8_SA(0, 1), cA, voffA1);
    if (wr == 1) PG8_BAR;
    PG8_WAIT_V(2); PG8_BAR;
    PG8_STAGE(PG8_SB(1, 0), cB + kstep, voffB); PG8_STAGE(PG8_SA(1, 0), cA + kstep, voffA0); PG8_STAGE(PG8_SB(1, 1), cB + hstepB + kstep, voffB);
    PG8_WAIT_V(6); PG8_BAR;
    for (;;) {
        const bool has_next = S.next(ui + 1, nxt);
        if (Sched::PARTIAL && has_next && nxt.late) S.acquire_late(tid);
        const char* nA = has_next ? nxt.a : cA; const char* nB = has_next ? nxt.b : cB;
        if (GATHER) { if (has_next) { int RA[2], CA[2]; { int tl_ = tid; asm volatile("" : "+v"(tl_)); stage_rc(tl_ * 16, RA[0], CA[0]); stage_rc(tl_ * 16 + 8192, RA[1], CA[1]); }     const int r4[4] = {RA[0], RA[1], HALF + RA[0], HALF + RA[1]}; unsigned o4[4]; S.row_off4(nxt, r4, o4);
                nA0[0] = o4[0] + (unsigned)(CA[0] * 2); nA0[1] = o4[1] + (unsigned)(CA[1] * 2); nA1[0] = o4[2] + (unsigned)(CA[0] * 2); nA1[1] = o4[3] + (unsigned)(CA[1] * 2); }
            else { nA0[0] = voffA0[0]; nA0[1] = voffA0[1]; nA1[0] = voffA1[0]; nA1[1] = voffA1[1]; } }
        constexpr bool act0 = true, act1 = true;
        for (int t = 0; t < nt; t += 2) {
            const bool last = (t == nt - 2); const int fresh = __builtin_amdgcn_readfirstlane((t == 0 && ui > 0) ? 1 : 0);
            const char* a1 = cA + (size_t)(t + 1) * kstep;
            const char* a2 = last ? nA : cA + (size_t)(t + 2) * kstep; const char* b2 = last ? nB : cB + (size_t)(t + 2) * kstep;
            const char* a3 = a2 + kstep; const char* b3 = b2 + kstep;
            unsigned x0[2], x1[2];
#pragma unroll
            for (int i = 0; i < 2; ++i) { x0[i] = (GATHER && last) ? nA0[i] : voffA0[i]; x1[i] = (GATHER && last) ? nA1[i] : voffA1[i]; }
            PG8_LDB(B0, 0, 0); PG8_LDB(B1, 0, 1); PG8_SCHED; PG8_LDA(At, 0, 0); PG8_STAGE(PG8_SA(1, 1), a1, voffA1);
            PG8_WAIT_V8_UNLESS(fresh); PG8_WAIT_L(0); PG8_BAR; if (act0) { PG8_MMA(0, 0, At, B0); PG8_MMA(0, 1, At, B1); } PG8_BAR; PG8_SCHED;
            PG8_LDA(At, 0, 1); PG8_STAGE(PG8_SB(0, 0), b2, voffB); PG8_STAGE(PG8_SB(0, 1), b2 + hstepB, voffB); PG8_STAGE(PG8_SA(0, 0), a2, x0);
            PG8_WAIT_V8_UNLESS(fresh); PG8_WAIT_L(0); PG8_BAR; if (act1) { PG8_MMA(1, 0, At, B0); PG8_MMA(1, 1, At, B1); } PG8_BAR; PG8_SCHED;
            PG8_LDB(B0, 1, 0); PG8_LDB(B1, 1, 1); PG8_SCHED; PG8_LDA(At, 1, 0); PG8_STAGE(PG8_SA(0, 1), a2, x1);
            PG8_WAIT_V(8); PG8_WAIT_L(0); PG8_BAR; if (act0) { PG8_MMA(0, 0, At, B0); PG8_MMA(0, 1, At, B1); } PG8_BAR; PG8_SCHED;
            PG8_LDA(At, 1, 1); PG8_STAGE(PG8_SB(1, 0), b3, voffB); PG8_STAGE(PG8_SB(1, 1), b3 + hstepB, voffB); PG8_STAGE(PG8_SA(1, 0), a3, x0);
            PG8_WAIT_V(8); PG8_WAIT_L(0); PG8_BAR; if (act1) { PG8_MMA(1, 0, At, B0); PG8_MMA(1, 1, At, B1); } PG8_BAR; PG8_SCHED;
        }
        PG8_WAIT_V(0);
        if (wr == 0) PG8_BAR;
        E(acc, cur, wr, wc, fr, fq);
        if (!has_next) break;
#pragma unroll
        for (int a = 0; a < 2; ++a)
#pragma unroll
            for (int b = 0; b < 2; ++b)
#pragma unroll
                for (int m = 0; m < 4; ++m)
#pragma unroll
                    for (int n = 0; n < 2; ++n) acc[a][b][m][n] = (f32x4){0.f, 0.f, 0.f, 0.f};
        cur = nxt; cA = nA; cB = nB; ++ui;
        if (GATHER) {
#pragma unroll
            for (int i = 0; i < 2; ++i) { voffA0[i] = nA0[i]; voffA1[i] = nA1[i]; } }
        if (wr == 1) PG8_BAR;
    }
    PG8_WAIT_V(0);
    PG8_BAR;
#undef PG8_SA
#undef PG8_SB
#undef PG8_STAGE
#undef PG8_LDA
#undef PG8_LDB
#undef PG8_MMA
#undef PG8_WAIT_V
#undef PG8_WAIT_L
#undef PG8_BAR
#undef PG8_SCHED
}
}

struct Args {
    const float* in[20]; float* out; unsigned char* ws; int ph_lo, ph_hi;
};
struct Frame {
    LAS unsigned char* lds; volatile LAS int* MISC;
    int tid, lane, wave, G, gw, NGW;
};

__constant__ float INV_FREQ[16] = {1.0f, 0.5623413251903491f, 0.31622776601683794f, 0.1778279410038923f, 0.1f, 0.05623413251903491f, 0.03162277660168379f, 0.01778279410038923f,
                                   0.01f, 0.005623413251903491f, 0.003162277660168379f, 0.001778279410038923f, 0.001f, 0.0005623413251903491f, 0.00031622776601683794f, 0.00017782794100389227f};

__device__ __forceinline__ void transpose_item(const float* W, int N, int k0, int scol0, int nvalid, const float* kscale, bf16_t* WT, int K, int drow0, LAS float* scr, int lane) {
    const int j = lane & 31;
    if (nvalid == 0) {
#pragma unroll
        for (int i = 0; i < 32; ++i) scr[(2 * i + (lane >> 5)) * 33 + j] = 0.f;
    } else {
        const int jc = j < nvalid ? j : 0;
        const float* src = W + (size_t)(k0 + (lane >> 5)) * N + scol0 + jc;
        float t[32];
#pragma unroll
        for (int i = 0; i < 32; ++i) t[i] = src[(size_t)(2 * i) * N];
#pragma unroll
        for (int i = 0; i < 32; ++i) { const int kk = 2 * i + (lane >> 5); float v = (j < nvalid) ? t[i] : 0.f; if (kscale) v *= kscale[k0 + kk]; scr[kk * 33 + j] = v; }
    }
    asm volatile("s_waitcnt lgkmcnt(0)" ::: "memory");
    const int c = lane & 7;
#pragma unroll
    for (int q = 0; q < 4; ++q) { const int n = (lane >> 3) + 8 * q; const LAS float* s = scr + (8 * c) * 33 + n;
        u32x4 o; o.x = cvtpk(s[0 * 33], s[1 * 33]); o.y = cvtpk(s[2 * 33], s[3 * 33]); o.z = cvtpk(s[4 * 33], s[5 * 33]); o.w = cvtpk(s[6 * 33], s[7 * 33]);
        *(u32x4*)(WT + (size_t)(drow0 + n) * K + k0 + 8 * c) = o; }
    asm volatile("s_waitcnt lgkmcnt(0)" ::: "memory");
}
template <class Map>
__device__ __forceinline__ void transpose_matrix(Frame& F, int& base, int it, const float* W, int K, int N, int Ndst, const float* kscale, bf16_t* WT, const Map& map, LAS float* scr, bool& done) {
    const int nblk = Ndst / 32, items = (K / 64) * nblk;
    if (!done && it >= base && it < base + items) { const int r = it - base, kb = r / nblk, nb = r % nblk; int scol0, nvalid, drow0; map(nb, scol0, nvalid, drow0);
        transpose_item(W, N, 64 * kb, scol0, nvalid, kscale, WT, K, drow0, scr, F.lane); done = true; }
    base += items;
}


struct XwItem { const float* src; int N; int k0; int scol; bf16_t* dst; int K; int drow0; const float* gain; };
__device__ __forceinline__ XwItem xw_decode(int it, const float* wg, const float* wu, const float* wd, const float* gain, bf16_t* gu_t, bf16_t* dn_t) {
    constexpr int per_gu = (1024 / 64) * (1024 / 32), items_gu = NEXP * per_gu, per_dn = (512 / 64) * (1024 / 32);
    XwItem x;
    if (it < items_gu) { const int e = it / per_gu, q = it % per_gu, kb = q / 32, nb = q % 32;
        const int pn = nb >> 3, within = nb & 7; const bool up = within >= 4;
        x.src = (up ? wu : wg) + (size_t)e * 1024 * 512; x.N = 512; x.k0 = 64 * kb; x.scol = 128 * pn + 32 * (within & 3); x.dst = gu_t + (size_t)e * 1024 * 1024; x.K = 1024; x.drow0 = 32 * nb; x.gain = gain; }
    else { const int r = it - items_gu, e = r / per_dn, q = r % per_dn, kb = q / 32, nb = q % 32;
        x.src = wd + (size_t)e * 512 * 1024; x.N = 1024; x.k0 = 64 * kb; x.scol = 32 * nb; x.dst = dn_t + (size_t)e * 1024 * 512; x.K = 512; x.drow0 = 32 * nb; x.gain = nullptr; }
    return x;
}
__device__ __forceinline__ void xw_load(const XwItem& x, int lane, f32x4 (&t)[8]) {
    const float* src = x.src + (size_t)(x.k0 + (lane >> 3)) * x.N + x.scol + 4 * (lane & 7);
#pragma unroll
    for (int i = 0; i < 8; ++i) t[i] = __builtin_nontemporal_load((const f32x4*)(src + (size_t)(8 * i) * x.N));
}
__device__ __forceinline__ void xw_finish(const XwItem& x, int lane, const f32x4 (&t)[8], LAS float* scr) {
    const int c = lane & 7;
    f32x4 g0 = {1.f, 1.f, 1.f, 1.f}, g1 = g0;
    if (x.gain) { g0 = *(const f32x4*)(x.gain + x.k0 + 8 * c); g1 = *(const f32x4*)(x.gain + x.k0 + 8 * c + 4); }
#pragma unroll
    for (int i = 0; i < 8; ++i)
#pragma unroll
        for (int jj = 0; jj < 4; ++jj) scr[(8 * i + (lane >> 3)) * 33 + 4 * c + jj] = t[i][jj];
    asm volatile("s_waitcnt lgkmcnt(0)" ::: "memory");
#pragma unroll
    for (int q = 0; q < 4; ++q) { const int n = (lane >> 3) + 8 * q; const LAS float* sp = scr + (8 * c) * 33 + n;
        u32x4 o; o.x = cvtpk(sp[0 * 33] * g0[0], sp[1 * 33] * g0[1]); o.y = cvtpk(sp[2 * 33] * g0[2], sp[3 * 33] * g0[3]); o.z = cvtpk(sp[4 * 33] * g1[0], sp[5 * 33] * g1[1]); o.w = cvtpk(sp[6 * 33] * g1[2], sp[7 * 33] * g1[3]);
        __builtin_nontemporal_store(o, (u32x4*)(x.dst + (size_t)(x.drow0 + n) * x.K + x.k0 + 8 * c)); }
    asm volatile("s_waitcnt lgkmcnt(0)" ::: "memory");
}
constexpr int XW_ITEMS = NEXP * ((1024 / 64) * (1024 / 32) + (512 / 64) * (1024 / 32)), XW_PER_WAVE = 6, XW_WG_ITEMS = XW_ITEMS / (NWAVES * XW_PER_WAVE);
static_assert(XW_WG_ITEMS * NWAVES * XW_PER_WAVE == XW_ITEMS, "expert conversion items");
__device__ __forceinline__ void xw_wg_item(int q, int wave, int lane, const float* wg, const float* wu, const float* wd, const float* gain, bf16_t* gu_t, bf16_t* dn_t, LAS float* scr) {
    const int it0 = (q * NWAVES + wave) * XW_PER_WAVE;
    f32x4 ta[8], tb[8];
    XwItem xa = xw_decode(it0, wg, wu, wd, gain, gu_t, dn_t), xb = xa;
    xw_load(xa, lane, ta);
#pragma unroll 1
    for (int k = 0; k < XW_PER_WAVE; k += 2) {
        xb = xw_decode(it0 + k + 1, wg, wu, wd, gain, gu_t, dn_t); xw_load(xb, lane, tb);
        xw_finish(xa, lane, ta, scr);
        if (k + 2 < XW_PER_WAVE) { xa = xw_decode(it0 + k + 2, wg, wu, wd, gain, gu_t, dn_t); xw_load(xa, lane, ta); }
        xw_finish(xb, lane, tb, scr);
    }
}

__device__ __forceinline__ float* hrow_ptr(float* out_real, float* h_meta, int m) { const int b = m / LSEQ, p = m - b * LSEQ; return p < 128 ? h_meta + (size_t)(b * 16 + (p - PADF)) * DM : out_real + (size_t)(b * SEQ + (p - 128)) * DM; }

__device__ __forceinline__ void store_xn_row(bf16_t* orow, const f32x4 (&v)[4], float rs, const f32x4 (&gg)[4], int lane) {
    u32x2* o8 = (u32x2*)orow + lane;
#pragma unroll
    for (int j = 0; j < 4; ++j) { u32x2 w; w.x = cvtpk(v[j].x * rs * gg[j].x, v[j].y * rs * gg[j].y); w.y = cvtpk(v[j].z * rs * gg[j].z, v[j].w * rs * gg[j].w); o8[64 * j] = w; }
}
__device__ __forceinline__ void zero_xn_row(bf16_t* orow, int lane) { u32x2* o8 = (u32x2*)orow + lane;
#pragma unroll
    for (int j = 0; j < 4; ++j) o8[64 * j] = (u32x2){0u, 0u}; }

__device__ __forceinline__ void moe_combine_row(f32x4 (&v)[4], const bf16_t* yrows, const int* tokp, const float* tokw, int m, int lane) {
    const int s0 = tokp[2 * m], s1 = tokp[2 * m + 1]; const float w0 = tokw[2 * m], w1 = tokw[2 * m + 1];
    const u32x2* y0 = (const u32x2*)(yrows + (size_t)s0 * DM) + lane; const u32x2* y1 = (const u32x2*)(yrows + (size_t)s1 * DM) + lane;
#pragma unroll
    for (int j = 0; j < 4; ++j) { const u32x2 a = y0[64 * j], b = y1[64 * j];
        v[j].x += w0 * bf_lo(a.x) + w1 * bf_lo(b.x); v[j].y += w0 * bf_hi(a.x) + w1 * bf_hi(b.x); v[j].z += w0 * bf_lo(a.y) + w1 * bf_lo(b.y); v[j].w += w0 * bf_hi(a.y) + w1 * bf_hi(b.y); }
}


struct NormCtx { const float* x; const float* meta; float* out; float* hmeta; bf16_t* hb; const float* g; float* rsa; const bf16_t* yrows; const int* toke; const int* tokp; const float* tokw; const volatile LAS int* tstart; };
template <int MODE, int NR>
__device__ __forceinline__ void norm_rows(const NormCtx& C, int m0, int mend, int lane) {
    f32x4 v[NR][4]; bool valid[NR]; float* hp[NR]; bf16_t* hbp[NR];
    f32x4 gg[4];
    if (MODE == 2) {
#pragma unroll
        for (int j = 0; j < 4; ++j) gg[j] = *((const f32x4*)C.g + lane + 64 * j); }
#pragma unroll
    for (int r = 0; r < NR; ++r) { const int m = m0 + r; valid[r] = false; hp[r] = nullptr; hbp[r] = nullptr;
        if (m < mend) {
            if (MODE == 2) { valid[r] = true; hp[r] = C.out + (size_t)m * DM; hbp[r] = C.hb + (size_t)m * DM; }
            else { const int b = m / LSEQ, p = m - b * LSEQ; valid[r] = (p >= PADF);
                if (valid[r]) { if (MODE == 0) hp[r] = (float*)(p < 128 ? C.meta + (size_t)(p - PADF) * DM : C.x + (size_t)(b * SEQ + p - 128) * DM);
                    else if (p < 128) hp[r] = C.hmeta + (size_t)(b * 16 + (p - PADF)) * DM; else hbp[r] = C.hb + (size_t)(b * SEQ + (p - 128)) * DM; } }
            if (valid[r]) {
                if (hbp[r]) { const u32x2* xr = (const u32x2*)hbp[r] + lane;
#pragma unroll
                    for (int j = 0; j < 4; ++j) { const u32x2 w = xr[64 * j]; v[r][j] = (f32x4){bf_lo(w.x), bf_hi(w.x), bf_lo(w.y), bf_hi(w.y)}; } }
                else { const f32x4* xr = (const f32x4*)hp[r] + lane;
#pragma unroll
                    for (int j = 0; j < 4; ++j) v[r][j] = __builtin_nontemporal_load(xr + 64 * j); } }
        } }
    if (MODE == 0) {
#pragma unroll
        for (int r = 0; r < NR; ++r) { const int m = m0 + r; const int b = m / LSEQ, p = m - b * LSEQ;
            if (m < mend && p >= PADF) { u32x2* hr = (u32x2*)(C.hb + (size_t)(p >= 128 ? b * SEQ + (p - 128) : HB_META + b * 16 + (p - PADF)) * DM) + lane;
#pragma unroll
                for (int j = 0; j < 4; ++j) hr[64 * j] = (u32x2){cvtpk(v[r][j].x, v[r][j].y), cvtpk(v[r][j].z, v[r][j].w)}; } }
    }
    if (MODE == 1 || MODE == 2) {
        u32x2 ya[NR][4], yb[NR][4]; float w0[NR], w1[NR]; int e0[NR], e1[NR], q0[NR], q1[NR];
#pragma unroll
        for (int r = 0; r < NR; ++r) { e0[r] = e1[r] = q0[r] = q1[r] = 0; w0[r] = w1[r] = 0.f;
            if (valid[r]) { int mt = m0 + r; if (MODE == 2) { const int b = mt / SEQ; mt = b * LSEQ + 128 + (mt - b * SEQ); }
                e0[r] = C.toke[2 * mt]; e1[r] = C.toke[2 * mt + 1]; q0[r] = C.tokp[2 * mt]; q1[r] = C.tokp[2 * mt + 1]; w0[r] = C.tokw[2 * mt]; w1[r] = C.tokw[2 * mt + 1]; } }
#pragma unroll
        for (int r = 0; r < NR; ++r) if (valid[r]) {
            const int f0 = (C.tstart[e0[r] + 1] - C.tstart[e0[r]]) * 256, f1 = (C.tstart[e1[r] + 1] - C.tstart[e1[r]]) * 256;
            const int s0 = q0[r] < f0 ? C.tstart[e0[r]] * 256 + q0[r] : C.tstart[96 + e0[r]] * 256 + (q0[r] - f0), s1 = q1[r] < f1 ? C.tstart[e1[r]] * 256 + q1[r] : C.tstart[96 + e1[r]] * 256 + (q1[r] - f1);
            const u32x2* y0 = (const u32x2*)(C.yrows + (size_t)s0 * DM) + lane; const u32x2* y1 = (const u32x2*)(C.yrows + (size_t)s1 * DM) + lane;
#pragma unroll
            for (int j = 0; j < 4; ++j) { ya[r][j] = __builtin_nontemporal_load(y0 + 64 * j); yb[r][j] = __builtin_nontemporal_load(y1 + 64 * j); } }
#pragma unroll
        for (int r = 0; r < NR; ++r) if (valid[r]) {
#pragma unroll
            for (int j = 0; j < 4; ++j) { const u32x2 a = ya[r][j], b = yb[r][j];
                v[r][j].x += w0[r] * bf_lo(a.x) + w1[r] * bf_lo(b.x); v[r][j].y += w0[r] * bf_hi(a.x) + w1[r] * bf_hi(b.x); v[r][j].z += w0[r] * bf_lo(a.y) + w1[r] * bf_lo(b.y); v[r][j].w += w0[r] * bf_hi(a.y) + w1[r] * bf_hi(b.y); }
            if (MODE == 1) {
                if (hbp[r]) { u32x2* hr = (u32x2*)hbp[r] + lane;
#pragma unroll
                    for (int j = 0; j < 4; ++j) hr[64 * j] = (u32x2){cvtpk(v[r][j].x, v[r][j].y), cvtpk(v[r][j].z, v[r][j].w)}; }
                else { f32x4* hr = (f32x4*)hp[r] + lane; const int mm = m0 + r, bb = mm / LSEQ, pp = mm - bb * LSEQ; u32x2* hc = (u32x2*)(C.hb + (size_t)(HB_META + bb * 16 + (pp - PADF)) * DM) + lane;
#pragma unroll
                    for (int j = 0; j < 4; ++j) { hr[64 * j] = v[r][j]; hc[64 * j] = (u32x2){cvtpk(v[r][j].x, v[r][j].y), cvtpk(v[r][j].z, v[r][j].w)}; } } } }
    }
    float ss[NR];
#pragma unroll
    for (int r = 0; r < NR; ++r) { ss[r] = 0.f; if (valid[r]) {
#pragma unroll
        for (int j = 0; j < 4; ++j) ss[r] += (v[r][j].x * v[r][j].x + v[r][j].y * v[r][j].y) + (v[r][j].z * v[r][j].z + v[r][j].w * v[r][j].w); } }
#pragma unroll
    for (int o = 1; o < 64; o <<= 1) {
#pragma unroll
        for (int r = 0; r < NR; ++r) ss[r] += shfl_xor_l(ss[r], o, lane); }
#pragma unroll
    for (int r = 0; r < NR; ++r) { const int m = m0 + r; if (m >= mend) continue;
        const float rs = __builtin_amdgcn_rsqf(ss[r] * (1.0f / DM) + EPS);
        if (MODE == 2) { f32x4* hr = (f32x4*)hp[r] + lane;
#pragma unroll
            for (int j = 0; j < 4; ++j) hr[64 * j] = (f32x4){v[r][j].x * rs * gg[j].x, v[r][j].y * rs * gg[j].y, v[r][j].z * rs * gg[j].z, v[r][j].w * rs * gg[j].w}; }
        else if (valid[r] && lane == 0) { const int b = m / LSEQ, p = m - b * LSEQ; C.rsa[p >= 128 ? b * SEQ + (p - 128) : NB * SEQ + b * 16 + (p - PADF)] = rs; } }
}

constexpr int AT_KP = 208;
constexpr int AT_KBUF = 64 * AT_KP, AT_VBUF = 8192, AT_FBUF = 256;
constexpr int AT_K0 = 0, AT_V0 = 4 * AT_KBUF, AT_F0 = AT_V0 + 4 * AT_VBUF, AT_END = AT_F0 + 4 * AT_FBUF;
static_assert(AT_END + 64 <= RING_BYTES, "attention LDS (+ 2 x 8 wave flags)");
struct AttnArgs { const bf16_t* proj; const bf16_t* qm; const bf16_t* km; const bf16_t* vm; const float* negf; const float* sinks; bf16_t* y; };

template <int VAR>
__device__ __forceinline__ void attn_unit(int tid, const AttnArgs& T, int b, int h, int u, LAS unsigned char* lds) {
    constexpr int DK = (VAR == 2) ? 96 : 64, NDS = DK / 16, KCH = DK / 8, KPB = DK * 2 + 16;
    const int lane = tid & 63, rr = lane & 31, hi = lane >> 5; const int wid = __builtin_amdgcn_readfirstlane(tid >> 6);
    const bf16_t *Qb, *Kb, *Vb; int qpitch, kpitch, vpitch;
    if (VAR == 0) { Qb = T.proj + C_AQ + 64 * h; Kb = T.proj + C_AK + 64 * (h >> 1); Vb = T.proj + C_AV + 64 * (h >> 1); qpitch = kpitch = vpitch = NPROJ; }
    else if (VAR == 1) { Qb = T.proj + C_FQ + 64 * h; Kb = T.proj + C_FK + 64 * h; Vb = T.proj + C_FV + 64 * h; qpitch = kpitch = vpitch = NPROJ; }
    else if (VAR == 2) { Qb = T.qm + 96 * h; Kb = T.km + 96 * h; Vb = T.vm + 64 * h; qpitch = kpitch = 384; vpitch = 256; }
    else { Qb = T.proj + C_SQ + 64 * h; Kb = T.proj + C_SK + 64 * h; Vb = T.proj + C_SV + 64 * h; qpitch = kpitch = vpitch = NPROJ; }
    const size_t rowb = (size_t)b * LSEQ;
    const int pq0 = (u < 0 ? -128 : 128 + 256 * u) + 32 * wid;
    const int pq = pq0 + rr;
    const bool wave_on = (pq0 + 31 >= PADF);
    const int cq = (u < 0) ? 0 : 4 * u + 1 + (wid >> 1);
    int ntile, t_first, t_step;
    if (u < 0) { ntile = 1; t_first = 1; t_step = 1; }
    else if (VAR == 0) { t_first = (u == 0) ? 2 : 4 * u; ntile = 4 * u + 5 - t_first + 2; t_step = 1; }
    else if (VAR == 3 || VAR == 1) { ntile = 4 * u + 5; t_first = 4 * u + 5; t_step = -1; }
    else { ntile = 4 * u + 5; t_first = 1; t_step = 1; }
#define TILE_OF(i) ((VAR == 0 && u >= 0) ? ((i) == 0 ? 1 : t_first + (i) - 1) : t_first + t_step * (i))
    bf16x8 qf[NDS];
    { const int pl = pq < 0 ? 0 : pq; const bf16_t* qrow = Qb + (rowb + pl) * qpitch + 8 * hi;
#pragma unroll
      for (int ds = 0; ds < NDS; ++ds) qf[ds] = *(const bf16x8*)(qrow + 16 * ds); }
    const int kr0 = tid / KCH, kc0 = tid % KCH;
    const int kr1 = (tid + 512) / KCH, kc1 = (tid + 512) % KCH;
    const bool k2 = (DK == 96) && (tid < 256);
    const int vr = tid >> 3, vc = tid & 7;
    const int v_lds = (vr >> 3) * 1024 + (vc >> 2) * 512 + (vr & 7) * 64 + (vc & 3) * 16;
    u32x4 kreg0a, kreg1a, vrega, kreg0b, kreg1b, vregb; f32x4 frega, fregb;
    kreg1a = (u32x4){0u, 0u, 0u, 0u}; kreg1b = kreg1a; frega = (f32x4){0.f, 0.f, 0.f, 0.f}; fregb = frega;
#define AT_LOAD(S_, j) do { const size_t r0_ = rowb + 64 * (size_t)(j); \
        kreg0##S_ = *(const u32x4*)(Kb + (r0_ + kr0) * kpitch + 8 * kc0); if (k2) kreg1##S_ = *(const u32x4*)(Kb + (r0_ + kr1) * kpitch + 8 * kc1); \
        vreg##S_ = *(const u32x4*)(Vb + (r0_ + vr) * vpitch + 8 * vc); \
        if (VAR == 1 && tid < 16) freg##S_ = *(const f32x4*)(T.negf + ((size_t)(b * 4 + h) * LSEQ + 64 * (j)) + 4 * tid); } while (0)
#define AT_WRITE(S_, buf) do { *(LAS u32x4*)(lds + AT_K0 + (buf) * AT_KBUF + kr0 * KPB + kc0 * 16) = kreg0##S_; if (k2) *(LAS u32x4*)(lds + AT_K0 + (buf) * AT_KBUF + kr1 * KPB + kc1 * 16) = kreg1##S_; \
        *(LAS u32x4*)(lds + AT_V0 + (buf) * AT_VBUF + v_lds) = vreg##S_; if (VAR == 1 && tid < 16) *(LAS f32x4*)(lds + AT_F0 + (buf) * AT_FBUF + 16 * tid) = freg##S_; } while (0)
    constexpr float ATT_THR = 8.0f;
    const float cs = ((VAR == 2) ? 0.10206207261596575f : 0.125f) * LOG2E;
#pragma unroll
    for (int ds = 0; ds < NDS; ++ds) { u32x4 w = __builtin_bit_cast(u32x4, qf[ds]);
#pragma unroll
        for (int k = 0; k < 4; ++k) w[k] = cvtpk(bf_lo(w[k]) * cs, bf_hi(w[k]) * cs);
        qf[ds] = __builtin_bit_cast(bf16x8, w); }
    float mhat = 0.f, l_run = 0.f, R_run = 1.0f, slope2 = 0.f; bool wave_dead = false;
    if (VAR == 0) { l_run = (hi == 0) ? __builtin_amdgcn_exp2f(T.sinks[h] * LOG2E) : 0.f; slope2 = __builtin_amdgcn_exp2f(-2.0f * (float)(h + 1)) * LOG2E; }
    f32x16 o0 = {}, o1 = {};
    const int vbase = (4 * hi + ((lane & 15) >> 2)) * 64 + ((lane >> 4) & 1) * 32 + (lane & 3) * 8;
    AT_LOAD(a, TILE_OF(0)); if (ntile > 1) AT_LOAD(b, TILE_OF(1));
    AT_WRITE(a, 0); if (ntile > 1) AT_WRITE(b, 1);
    __syncthreads();
    auto compute_tile = [&](const int j, const int buf) __attribute__((always_inline)) {
        const int cj = j - 1;
        bool doit = wave_on && (cj <= cq) && !wave_dead;
        if (VAR == 0) doit = doit && (j == 1 || cj >= cq - 2);
        if (doit) {
            const LAS unsigned char* Kt = lds + AT_K0 + buf * AT_KBUF; const LAS unsigned char* Vt = lds + AT_V0 + buf * AT_VBUF;
            f32x16 p0, p1;
            { const float nm = (VAR == 3) ? 0.f : -mhat;
#pragma unroll
              for (int r = 0; r < 16; ++r) { p0[r] = nm; p1[r] = nm; } }
            { bf16x8 kf[2 * NDS];
#pragma unroll
              for (int ds = 0; ds < NDS; ++ds) { kf[2 * ds] = *(const LAS bf16x8*)(Kt + rr * KPB + (2 * ds + hi) * 16); kf[2 * ds + 1] = *(const LAS bf16x8*)(Kt + (32 + rr) * KPB + (2 * ds + hi) * 16); }
              __builtin_amdgcn_sched_group_barrier(0x100, 2 * NDS, 0);
#pragma unroll
              for (int ds = 0; ds < NDS; ++ds) {
                p0 = __builtin_amdgcn_mfma_f32_32x32x16_bf16(kf[2 * ds], qf[ds], p0, 0, 0, 0);
                p1 = __builtin_amdgcn_mfma_f32_32x32x16_bf16(kf[2 * ds + 1], qf[ds], p1, 0, 0, 0);
              }
              __builtin_amdgcn_sched_group_barrier(0x008, 2 * NDS, 0); }
            const bool need_mask = (j == 1) || ((VAR == 1 || VAR == 3) && cj == cq);
            const int pk0 = 64 * j + 4 * hi;
            unsigned pw[16];
            bool skip_pv = false;
            if (VAR != 3) {
                if (VAR == 1) {
                    const LAS float* Ft = (const LAS float*)(lds + AT_F0 + buf * AT_FBUF);
#pragma unroll
                    for (int g = 0; g < 4; ++g) { const f32x4 f0 = *(const LAS f32x4*)(Ft + 8 * g + 4 * hi), f1 = *(const LAS f32x4*)(Ft + 32 + 8 * g + 4 * hi);
#pragma unroll
                        for (int k = 0; k < 4; ++k) { p0[4 * g + k] += f0[k]; p1[4 * g + k] += f1[k]; } }
                } else if (VAR == 0) {
                    const float dq = (float)(pq - pk0); const float cap = (j == 1) ? 128.0f : 1e30f;
#pragma unroll
                    for (int r = 0; r < 16; ++r) { const float c0 = (float)(8 * (r >> 2) + (r & 3));
                        p0[r] = fmaf(-slope2, fminf(fabsf(dq - c0), cap), p0[r]); p1[r] = fmaf(-slope2, fminf(fabsf(dq - (c0 + 32.0f)), cap), p1[r]); }
                }
                if (need_mask) {
#pragma unroll
                    for (int r = 0; r < 16; ++r) { const int pk = pk0 + 8 * (r >> 2) + (r & 3);
                        bool v0 = (pk >= PADF), v1 = (pk + 32 >= PADF); if (VAR == 1) { v0 = v0 && (pk <= pq); v1 = v1 && (pk + 32 <= pq); }
                        if (!v0) p0[r] = -1e30f; if (!v1) p1[r] = -1e30f; }
                }
                float mxa = fmaxf(fmaxf(p0[0], p0[1]), p1[0]), mxb = fmaxf(fmaxf(p0[2], p0[3]), p1[1]); mxa = fmaxf(fmaxf(mxa, p1[2]), p1[3]);
#pragma unroll
                for (int r = 4; r < 16; r += 4) { mxa = fmaxf(fmaxf(mxa, p0[r]), p0[r + 1]); mxb = fmaxf(fmaxf(mxb, p0[r + 2]), p0[r + 3]); mxa = fmaxf(fmaxf(mxa, p1[r]), p1[r + 1]); mxb = fmaxf(fmaxf(mxb, p1[r + 2]), p1[r + 3]); }
                const float rm = swap_max(fmaxf(mxa, mxb));
                const bool tile_zero = __all(rm < -200.0f);
                if (!tile_zero) {
                if (__any(rm > ATT_THR)) {
                    const float dl = fmaxf(rm, 0.f); mhat += dl;
#pragma unroll
                    for (int r = 0; r < 16; ++r) { p0[r] -= dl; p1[r] -= dl; }
                    const float f = __builtin_amdgcn_exp2f(-dl); l_run *= f;
#pragma unroll
                    for (int r = 0; r < 16; ++r) { o0[r] *= f; o1[r] *= f; }
                }
                float lsa = 0.f, lsb = 0.f;
#pragma unroll
                for (int r = 0; r < 16; ++r) { p0[r] = __builtin_amdgcn_exp2f(p0[r]); p1[r] = __builtin_amdgcn_exp2f(p1[r]); lsa += p0[r]; lsb += p1[r]; }
                l_run += lsa + lsb;
                }
                skip_pv = tile_zero;
            } else {
                float e0[4], e1[4];
#pragma unroll
                for (int r = 0; r < 16; ++r) {
                    float k0 = __builtin_amdgcn_rcpf(1.0f + __builtin_amdgcn_exp2f(p0[r])), k1 = __builtin_amdgcn_rcpf(1.0f + __builtin_amdgcn_exp2f(p1[r]));
                    if (need_mask) { const int pk = pk0 + 8 * (r >> 2) + (r & 3);
                        if (!((pk >= PADF) && (pk < pq))) k0 = 1.0f; if (!((pk + 32 >= PADF) && (pk + 32 < pq))) k1 = 1.0f; }
                    p0[r] = k0; p1[r] = k1;
                    if ((r & 3) == 0) { e0[r >> 2] = k0; e1[r >> 2] = k1; } else { e0[r >> 2] *= k0; e1[r >> 2] *= k1; }
                }
                float E[8], Od[8];
#pragma unroll
                for (int g = 0; g < 4; ++g) { swap_both(e0[g], E[g], Od[g]); swap_both(e1[g], E[4 + g], Od[4 + g]); }
                float run = R_run, sufE[8], sufO[8];
#pragma unroll
                for (int g = 7; g >= 0; --g) { sufO[g] = run; run *= Od[g]; sufE[g] = run; run *= E[g]; }
                R_run = run; wave_dead = __all(run == 0.f);
#pragma unroll
                for (int g = 0; g < 4; ++g) {
                    float b0 = hi ? sufO[g] : sufE[g], b1 = hi ? sufO[4 + g] : sufE[4 + g];
#pragma unroll
                    for (int k = 3; k >= 0; --k) { const float t0 = p0[4 * g + k] * b0, t1 = p1[4 * g + k] * b1; p0[4 * g + k] = b0 - t0; p1[4 * g + k] = b1 - t1; b0 = t0; b1 = t1; }
                }
            }
            if (!skip_pv) {
#pragma unroll
            for (int r = 0; r < 8; ++r) { pw[r] = cvtpk(p0[2 * r], p0[2 * r + 1]); pw[8 + r] = cvtpk(p1[2 * r], p1[2 * r + 1]); }
            { s16x4 vlo[8], vhi[8];
#pragma unroll
              for (int s = 0; s < 4; ++s)
#pragma unroll
                for (int dh = 0; dh < 2; ++dh) { const LAS unsigned char* vp = Vt + vbase + (2 * s) * 1024 + dh * 512;
                    vlo[2 * s + dh] = __builtin_bit_cast(s16x4, __builtin_amdgcn_ds_read_tr16_b64_v4i16((LAS s16x4*)vp));
                    vhi[2 * s + dh] = __builtin_bit_cast(s16x4, __builtin_amdgcn_ds_read_tr16_b64_v4i16((LAS s16x4*)(vp + 1024))); }
              __builtin_amdgcn_sched_group_barrier(0x100, 16, 0);
#pragma unroll
              for (int s = 0; s < 4; ++s) {
                const u32x4 pf4 = {pw[4 * s], pw[4 * s + 1], pw[4 * s + 2], pw[4 * s + 3]}; const bf16x8 pf = __builtin_bit_cast(bf16x8, pf4);
#pragma unroll
                for (int dh = 0; dh < 2; ++dh) { const s16x4 lo = vlo[2 * s + dh], hh = vhi[2 * s + dh];
                    const bf16x8 vf = {lo[0], lo[1], lo[2], lo[3], hh[0], hh[1], hh[2], hh[3]};
                    if (dh == 0) o0 = __builtin_amdgcn_mfma_f32_32x32x16_bf16(vf, pf, o0, 0, 0, 0); else o1 = __builtin_amdgcn_mfma_f32_32x32x16_bf16(vf, pf, o1, 0, 0, 0);
                }
              }
              __builtin_amdgcn_sched_group_barrier(0x008, 8, 0); }
            }
        }
    };
    for (int i0 = 0; i0 < ntile; i0 += 2) {
        const int base = i0 & 2;
        if (i0 + 2 < ntile) AT_LOAD(a, TILE_OF(i0 + 2));
        if (i0 + 3 < ntile) AT_LOAD(b, TILE_OF(i0 + 3));
        compute_tile(TILE_OF(i0), base);
        if (i0 + 1 < ntile) compute_tile(TILE_OF(i0 + 1), base + 1);
        if (i0 + 2 < ntile) AT_WRITE(a, base ^ 2);
        if (i0 + 3 < ntile) AT_WRITE(b, (base ^ 2) + 1);
        if (VAR == 3) {
            volatile LAS int* fl = (volatile LAS int*)(lds + AT_END) + 8 * ((i0 >> 1) & 1);
            if (lane == 0) fl[wid] = (!wave_on || wave_dead) ? 1 : 0;
            __syncthreads();
            const u32x4 fa = *(const LAS u32x4*)(lds + AT_END + 32 * ((i0 >> 1) & 1)), fb = *(const LAS u32x4*)(lds + AT_END + 32 * ((i0 >> 1) & 1) + 16);
            if (fa.x & fa.y & fa.z & fa.w & fb.x & fb.y & fb.z & fb.w) break; }
        else __syncthreads();
    }
    const float l_tot = swap_sum(l_run);
    if (wave_on) {
        const float inv = (VAR != 3) ? 1.0f / l_tot : 1.0f;
        LAS unsigned char* st = lds + wid * 4608;
#pragma unroll
        for (int g = 0; g < 4; ++g) {
            const u32x2 w0 = {cvtpk(o0[4 * g] * inv, o0[4 * g + 1] * inv), cvtpk(o0[4 * g + 2] * inv, o0[4 * g + 3] * inv)};
            const u32x2 w1 = {cvtpk(o1[4 * g] * inv, o1[4 * g + 1] * inv), cvtpk(o1[4 * g + 2] * inv, o1[4 * g + 3] * inv)};
            *(LAS u32x2*)(st + rr * 144 + 8 * hi + 16 * g) = w0; *(LAS u32x2*)(st + rr * 144 + 64 + 8 * hi + 16 * g) = w1;
        }
        const int sr = lane >> 3, sc = lane & 7;
        bf16_t* ybase = T.y + (rowb + pq0 + sr) * DM + 256 * VAR + 64 * h + 8 * sc;
#pragma unroll
        for (int j = 0; j < 4; ++j) { const u32x4 v = *(const LAS u32x4*)(st + (8 * j + sr) * 144 + 16 * sc); if (pq0 + 8 * j + sr >= PADF) *(u32x4*)(ybase + (size_t)(8 * j) * DM) = v; }
    }
    __syncthreads();
#undef TILE_OF
#undef AT_LOAD
#undef AT_WRITE
}

__device__ __forceinline__ void st4bf(bf16_t* p, float a, float b, float c, float d) { u32x2 w = {cvtpk(a, b), cvtpk(c, d)}; *(u32x2*)p = w; }
__device__ __forceinline__ float sumsq8(bf16x8 v) { float s = 0.f;
#pragma unroll
    for (int i = 0; i < 8; ++i) { const float f = bf2f((bf16_t)v[i]); s += f * f; } return s; }

__device__ __forceinline__ void mla_task(int bi, int qa, int qb, int ka, int kb, const bf16_t* proj, const bf16_t* Wuq, const bf16_t* Wukv, const f32x2* rope, bf16_t* qm, bf16_t* km, bf16_t* vm, int lane, LAS unsigned char* st) {
    const int rr = lane & 31, hi = lane >> 5;
    const int m = bi < NB * 128 ? (bi >> 7) * LSEQ + 128 + 32 * (bi & 127) + rr : (2 * (bi - NB * 128) + (rr >> 4)) * LSEQ + PADF + (rr & 15);
    const int pos = m % LSEQ - PADF;
    const int sr = lane >> 2, sc = lane & 3;
    const int M0 = (bi < NB * 128 ? (bi >> 7) * LSEQ + 128 + 32 * (bi & 127) : (2 * (bi - NB * 128)) * LSEQ + PADF) + sr, M1 = (bi < NB * 128 ? M0 + 16 : M0 + LSEQ);
#define MLA_STORE(dst_, ld_, col_, a_) do { \
        _Pragma("unroll") for (int g = 0; g < 4; ++g) { const u32x2 w_ = {cvtpk(a_[4 * g], a_[4 * g + 1]), cvtpk(a_[4 * g + 2], a_[4 * g + 3])}; *(LAS u32x2*)(st + rr * 80 + 8 * hi + 16 * g) = w_; } \
        const u32x4 v0_ = *(LAS u32x4*)(st + sr * 80 + 16 * sc), v1_ = *(LAS u32x4*)(st + (sr + 16) * 80 + 16 * sc); \
        *(u32x4*)((dst_) + (size_t)M0 * (ld_) + (col_) + 8 * sc) = v0_; *(u32x4*)((dst_) + (size_t)M1 * (ld_) + (col_) + 8 * sc) = v1_; } while (0)
    const bf16_t* prow = proj + (size_t)m * NPROJ;
    const f32x2* rt = rope + (size_t)pos * 16;
    if (qa < qb) {
        bf16x8 cq[16]; float ss = 0.f;
#pragma unroll
        for (int ks = 0; ks < 16; ++ks) { cq[ks] = *(const bf16x8*)(prow + C_CQ + 16 * ks + 8 * hi); ss += sumsq8(cq[ks]); }
        ss = swap_sum(ss); const float rs = __builtin_amdgcn_rsqf(ss * (1.0f / 256.0f) + EPS);
        bf16x8 wa[8], wb[8]; f32x16 acc = {};
#define MLA_LOADQ(dst, nb_, kh_) do { const bf16_t* wf_ = Wuq + (size_t)(nb_) * 8192 + (kh_) * 4096 + lane * 8; _Pragma("unroll") for (int ks = 0; ks < 8; ++ks) dst[ks] = *(const bf16x8*)(wf_ + ks * 512); } while (0)
#define MLA_DOQ(src, nb_, kh_) do { \
            _Pragma("unroll") for (int ks = 0; ks < 8; ++ks) acc = __builtin_amdgcn_mfma_f32_32x32x16_bf16(src[ks], cq[8 * (kh_) + ks], acc, 0, 0, 0); \
            if (kh_) { _Pragma("unroll") for (int r = 0; r < 16; ++r) acc[r] *= rs; \
              const int head = nb_ / 3, part = nb_ - 3 * head; \
              if (part == 2) { _Pragma("unroll") for (int r = 0; r < 8; ++r) { const f32x2 cs = rt[crow(r, hi)]; const float x1 = acc[r], x2 = acc[r + 8]; acc[r] = x1 * cs.x - x2 * cs.y; acc[r + 8] = x1 * cs.y + x2 * cs.x; } } \
              MLA_STORE(qm, 384, 96 * head + 32 * part, acc); \
              acc = (f32x16){}; } } while (0)
        MLA_LOADQ(wa, qa, 0);
#pragma unroll 1
        for (int nb = qa; nb < qb; ++nb) { MLA_LOADQ(wb, nb, 1); MLA_DOQ(wa, nb, 0); if (nb + 1 < qb) MLA_LOADQ(wa, nb + 1, 0); MLA_DOQ(wb, nb, 1); }
#undef MLA_LOADQ
#undef MLA_DOQ
    }
    if (ka < kb) {
        bf16x8 ck[8]; float ss = 0.f;
#pragma unroll
        for (int ks = 0; ks < 8; ++ks) { ck[ks] = *(const bf16x8*)(prow + C_CKV + 16 * ks + 8 * hi); ss += sumsq8(ck[ks]); }
        ss = swap_sum(ss); const float rs = __builtin_amdgcn_rsqf(ss * (1.0f / 128.0f) + EPS);
        bf16x8 wa[8], wb[8];
#define MLA_LOADK(dst, nb_) do { const bf16_t* wf_ = Wukv + (size_t)(nb_) * 4096 + lane * 8; _Pragma("unroll") for (int ks = 0; ks < 8; ++ks) dst[ks] = *(const bf16x8*)(wf_ + ks * 512); } while (0)
#define MLA_DOK(src, nb_) do { f32x16 acc = {}; _Pragma("unroll") for (int ks = 0; ks < 8; ++ks) acc = __builtin_amdgcn_mfma_f32_32x32x16_bf16(src[ks], ck[ks], acc, 0, 0, 0); \
            const int head = (nb_) >> 2, part = (nb_) & 3; \
            _Pragma("unroll") for (int r = 0; r < 16; ++r) acc[r] *= rs; \
            if (part < 2) MLA_STORE(km, 384, 96 * head + 32 * part, acc); else MLA_STORE(vm, 256, 64 * head + 32 * (part - 2), acc); } while (0)
        MLA_LOADK(wa, 2 * ka);
#pragma unroll 1
        for (int kp = ka; kp < kb; ++kp) { const int nb = 2 * kp; MLA_LOADK(wb, nb + 1); MLA_DOK(wa, nb); if (kp + 1 < kb) MLA_LOADK(wa, nb + 2); MLA_DOK(wb, nb + 1); }
#undef MLA_LOADK
#undef MLA_DOK
        if (kb == 8) {
            const bf16x8 x1 = *(const bf16x8*)(prow + C_CKR + 8 * hi), x2 = *(const bf16x8*)(prow + C_CKR + 16 + 8 * hi);
            float o1[8], o2[8];
#pragma unroll
            for (int t = 0; t < 8; ++t) { const f32x2 cs = rt[8 * hi + t]; const float a = bf2f((bf16_t)x1[t]), b = bf2f((bf16_t)x2[t]); o1[t] = a * cs.x - b * cs.y; o2[t] = a * cs.y + b * cs.x; }
            const u32x4 w1 = {cvtpk(o1[0], o1[1]), cvtpk(o1[2], o1[3]), cvtpk(o1[4], o1[5]), cvtpk(o1[6], o1[7])}, w2 = {cvtpk(o2[0], o2[1]), cvtpk(o2[2], o2[3]), cvtpk(o2[4], o2[5]), cvtpk(o2[6], o2[7])};
#pragma unroll
            for (int hd = 0; hd < 4; ++hd) { bf16_t* o = km + (size_t)m * 384 + 96 * hd + 64 + 8 * hi; *(u32x4*)o = w1; *(u32x4*)(o + 16) = w2; }
        }
    }
#undef MLA_STORE
}


template <bool RESID>
__device__ __forceinline__ void meta_side_task(int t, int nN32, const bf16_t* A, const bf16_t* Bt, bf16_t* outb, int ldo, const float* base_meta, int base_bstride, float* hmeta, LAS unsigned char* lds, int lane, int wave) {
    const int blk = t / nN32, nb = t - blk * nN32, rr = lane & 31, hi = lane >> 5;
    const int b = 2 * blk + (rr >> 4), i = rr & 15; const size_t m = (size_t)b * LSEQ + PADF + i;
    const bf16_t* arow = A + (RESID ? m : (size_t)(b * 16 + i)) * DM + 8 * hi + 128 * wave; const bf16_t* wrow = Bt + (size_t)(32 * nb + rr) * DM + 8 * hi + 128 * wave;
    bf16x8 wf[8], af[8];
#pragma unroll
    for (int ks = 0; ks < 8; ++ks) { wf[ks] = *(const bf16x8*)(wrow + 16 * ks); af[ks] = *(const bf16x8*)(arow + 16 * ks); }
    f32x16 acc = {};
#pragma unroll
    for (int ks = 0; ks < 8; ++ks) acc = __builtin_amdgcn_mfma_f32_32x32x16_bf16(wf[ks], af[ks], acc, 0, 0, 0);
    LAS float* part = (LAS float*)lds;
#pragma unroll
    for (int r = 0; r < 16; ++r) part[(wave * 16 + r) * 64 + lane] = acc[r];
    __syncthreads();
#pragma unroll
    for (int q = 0; q < 2; ++q) { const int r = 2 * wave + q; float sum = 0.f;
#pragma unroll
        for (int w = 0; w < 8; ++w) sum += part[(w * 16 + r) * 64 + lane];
        const int n = 32 * nb + crow(r, hi);
        if (!RESID) outb[m * ldo + n] = (bf16_t)(cvtpk(sum * base_meta[NB * SEQ + b * 16 + i], 0.f) & 0xffffu);
        else { const float hv = base_meta[(size_t)(b * base_bstride + i) * DM + n] + sum; hmeta[(size_t)(b * 16 + i) * DM + n] = hv; outb[(size_t)(b * 16 + i) * DM + n] = (bf16_t)(cvtpk(hv, 0.f) & 0xffffu); } }
    __syncthreads();
}

__device__ __forceinline__ void fscan_unit(int b, const bf16_t* proj, const float* bforget, float* negf, LAS unsigned char* lds, int tid) {
    LAS float* part = (LAS float*)lds;
    constexpr int PER = 9;
    float bf[4]; for (int hh = 0; hh < 4; ++hh) bf[hh] = bforget[hh];
    float loc[PER][4]; float s[4] = {0.f, 0.f, 0.f, 0.f};
#pragma unroll
    for (int i = 0; i < PER; ++i) { const int p = tid * PER + i;
        u32x2 w = {0u, 0u}; if (p < LSEQ) w = *(const u32x2*)(proj + ((size_t)b * LSEQ + p) * NPROJ + C_FG);
        const float fg[4] = {bf_lo(w.x), bf_hi(w.x), bf_lo(w.y), bf_hi(w.y)};
#pragma unroll
        for (int hh = 0; hh < 4; ++hh) { const float x = fg[hh] + bf[hh];
            const float ls = fminf(x, 0.f) - __logf(1.0f + __expf(-fabsf(x))); s[hh] += (p >= PADF && p < LSEQ) ? ls : 0.f; loc[i][hh] = s[hh]; } }
    const int ln = tid & 63, wv = tid >> 6; float offs[4];
#pragma unroll
    for (int hh = 0; hh < 4; ++hh) { float inc = s[hh];
#pragma unroll
        for (int d = 1; d < 64; d <<= 1) { const float o = __int_as_float(__builtin_amdgcn_ds_bpermute(4 * (ln - d), __float_as_int(inc))); inc += ln >= d ? o : 0.f; }
        if (ln == 63) part[wv * 4 + hh] = inc;
        offs[hh] = inc - s[hh]; }
    __syncthreads();
#pragma unroll
    for (int hh = 0; hh < 4; ++hh) {
#pragma unroll
        for (int w2 = 0; w2 < 7; ++w2) offs[hh] += w2 < wv ? part[w2 * 4 + hh] : 0.f; }
#pragma unroll
    for (int hh = 0; hh < 4; ++hh) { const float off = offs[hh];
#pragma unroll
        for (int i = 0; i < PER; ++i) { const int p = tid * PER + i; if (p < LSEQ) negf[((size_t)(b * 4 + hh)) * LSEQ + p] = -(off + loc[i][hh]) * LOG2E; } }
    __syncthreads();
}

__device__ __forceinline__ void router_phase(Frame& F, const bf16_t* hb, const bf16_t* Wrt, const float* bgroup, const float* brouter, unsigned* cnt, int* toke, float* tokw, int* tokp, int* elist, float* rsl) {
    const int lane = F.lane, rr = lane & 31, hi = lane >> 5;
    volatile LAS int* hist = F.MISC + 128;
    constexpr int NBLK = HB_ZERO / 32;
    for (int blk0 = 0; blk0 < NBLK; blk0 += F.NGW) {
    const int blk = blk0 + F.wave * F.G + (int)blockIdx.x;
    const bool active = blk < NBLK;
    if (F.tid < 32) hist[F.tid] = 0;
    __syncthreads();
    int e1 = 0, e2 = 0, r1 = 0, r2 = 0; float w1v = 0.f, w2v = 0.f, rs = 0.f; const int hrow = blk * 32 + rr;
    if (active) {
    const bf16_t* xrow = hb + (size_t)hrow * DM + 8 * hi; const bf16_t* w0 = Wrt + lane * 8; const bf16_t* w1 = Wrt + 32768 + (size_t)(rr & 3) * DM + 8 * hi;
    f32x16 a0 = {}, a1 = {}; float ss = 0.f;
#pragma unroll 1
    for (int k8 = 0; k8 < 64; k8 += 8) {
        bf16x8 xb[8], wa[8]; u32x4 wbu[8];
#pragma unroll
        for (int q = 0; q < 8; ++q) { xb[q] = *(const bf16x8*)(xrow + 16 * (k8 + q)); wa[q] = *(const bf16x8*)(w0 + (k8 + q) * 512); wbu[q] = *(const u32x4*)(w1 + 16 * (k8 + q)); }
#pragma unroll
        for (int q = 0; q < 8; ++q) { if (rr >= 4) wbu[q] = (u32x4){0u, 0u, 0u, 0u}; ss += sumsq8(xb[q]);
            a0 = __builtin_amdgcn_mfma_f32_32x32x16_bf16(wa[q], xb[q], a0, 0, 0, 0); a1 = __builtin_amdgcn_mfma_f32_32x32x16_bf16(__builtin_bit_cast(bf16x8, wbu[q]), xb[q], a1, 0, 0, 0); } }
    ss = swap_sum(ss); rs = __builtin_amdgcn_rsqf(ss * (1.0f / DM) + EPS);
    float gl[4];
#pragma unroll
    for (int i = 0; i < 4; ++i) { float lo, hh; swap_both(a1[i], lo, hh); gl[i] = lo * rs + bgroup[i]; }
    int gt = 0; float gmax = gl[0];
#pragma unroll
    for (int i = 1; i < 4; ++i) if (gl[i] > gmax) { gmax = gl[i]; gt = i; }
    float gs = 0.f;
#pragma unroll
    for (int i = 0; i < 4; ++i) gs += __expf(gl[i] - gmax);
    const float gwt = 1.0f / gs;
    float mine[4];
#pragma unroll
    for (int t = 0; t < 4; ++t) mine[t] = (gt == 0) ? a0[t] : (gt == 1) ? a0[4 + t] : (gt == 2) ? a0[8 + t] : a0[12 + t];
    float el[8];
#pragma unroll
    for (int t = 0; t < 4; ++t) { float lo, hh; swap_both(mine[t], lo, hh); el[t] = lo * rs + brouter[8 * gt + t]; el[4 + t] = hh * rs + brouter[8 * gt + 4 + t]; }
    int i1 = 0; float v1 = el[0];
#pragma unroll
    for (int t = 1; t < 8; ++t) if (el[t] > v1) { v1 = el[t]; i1 = t; }
    int i2 = -1; float v2 = -3.0e38f;
#pragma unroll
    for (int t = 0; t < 8; ++t) if (t != i1 && el[t] > v2) { v2 = el[t]; i2 = t; }
    const float ex = __expf(v2 - v1); w1v = gwt / (1.0f + ex); w2v = gwt * ex / (1.0f + ex);
    e1 = 8 * gt + i1; e2 = 8 * gt + i2;
    if (hi == 0) { r1 = __hip_atomic_fetch_add((LAS int*)&hist[e1], 1, __ATOMIC_RELAXED, __HIP_MEMORY_SCOPE_WORKGROUP); r2 = __hip_atomic_fetch_add((LAS int*)&hist[e2], 1, __ATOMIC_RELAXED, __HIP_MEMORY_SCOPE_WORKGROUP); }
    }
    __syncthreads();
    if (F.tid < 32) { const int c = hist[F.tid]; hist[32 + F.tid] = c ? (int)atomicAdd(cnt + F.tid, (unsigned)c) : 0; }
    __syncthreads();
    if (active && hi == 0) { const int p1 = hist[32 + e1] + r1, p2 = hist[32 + e2] + r2;
        int m; if (hrow < HB_META) { const int b = hrow >> 12, t = hrow & (SEQ - 1); m = b * LSEQ + 128 + t; } else { const int q = hrow - HB_META; m = (q >> 4) * LSEQ + PADF + (q & 15); }
        elist[(size_t)e1 * MROWS + p1] = hrow; elist[(size_t)e2 * MROWS + p2] = hrow; rsl[(size_t)e1 * MROWS + p1] = rs; rsl[(size_t)e2 * MROWS + p2] = rs;
        toke[2 * m] = e1; toke[2 * m + 1] = e2; tokw[2 * m] = w1v; tokw[2 * m + 1] = w2v; tokp[2 * m] = p1; tokp[2 * m + 1] = p2; }
    __syncthreads();
    }
}

__device__ __forceinline__ void expert_tiles_to_lds(Frame& F, const unsigned* cnt) {
    if (F.tid < 64) { const int lane = F.tid; const int c = (lane < NEXP) ? (int)cnt[lane] : 0; const int nfull = c >> 8, rem = c & 255; int incl = nfull;
#pragma unroll
        for (int o = 1; o < 32; o <<= 1) { const int v = shfl_up_l(incl, o, lane); if (lane >= o) incl += v; }
        const int nf = __builtin_amdgcn_ds_bpermute(4 * (NEXP - 1), incl);
        int rank = 0, np = 0;
#pragma unroll
        for (int k = 0; k < NEXP; ++k) { const int rk = __builtin_amdgcn_ds_bpermute(4 * k, rem); rank += (rk > rem || (rk == rem && k < lane)) ? 1 : 0; np += rk > 0 ? 1 : 0; }
        if (lane < NEXP) { F.MISC[lane] = incl - nfull; F.MISC[64 + lane] = c; F.MISC[96 + lane] = nf + rank; if (rem > 0) F.MISC[128 + rank] = lane; }
        if (lane == NEXP - 1) { F.MISC[NEXP] = nf; F.MISC[NEXP + 1] = nf + np; } }
    __syncthreads();
}

#define XB_TMO      128
#define XB_XCNT(j)  (256  + 64 * (j))
#define XB_XSUB(j)  (1280 + 64 * (j))
#define XB_XGEN(j)  (2304 + 64 * (j))
#define XB_TOP      3328
#define XB_TOPGEN   3392
#define XCD_BAR_WORDS 3456
#define XB_SPIN_CAP (1u << 20)
__device__ __forceinline__ unsigned xb_ld(unsigned* p)              { return __hip_atomic_load(p, __ATOMIC_RELAXED, __HIP_MEMORY_SCOPE_AGENT); }
__device__ __forceinline__ unsigned xb_add(unsigned* p, unsigned v) { return __hip_atomic_fetch_add(p, v, __ATOMIC_RELAXED, __HIP_MEMORY_SCOPE_AGENT); }
__device__ __forceinline__ unsigned xb_xcc_id() { return (unsigned)__builtin_amdgcn_s_getreg((3 << 11) | 20) & 0xFu; }
#define XB_SPIN(cond, bar) do { unsigned _sp = 0; while (cond) { __builtin_amdgcn_s_sleep(1); \
    if ((++_sp & 255u) == 0u) { if (xb_ld(&(bar)[XB_TMO])) break; if (_sp > XB_SPIN_CAP) { atomicAdd(&(bar)[XB_TMO], 1u); break; } } } } while (0)
struct XcdBarrier { unsigned* bar; unsigned x; volatile LAS unsigned* st; };
__device__ __forceinline__ XcdBarrier xcd_barrier_post(unsigned* bar, volatile LAS unsigned* st) {
    XcdBarrier b; b.bar = bar; b.x = xb_xcc_id(); b.st = st;
    if (threadIdx.x == 0) (void)xb_add(&bar[XB_XCNT(b.x)], 1u);
    return b;
}
__device__ __forceinline__ void xcd_barrier_complete(unsigned* bar, unsigned x, unsigned& nloc, unsigned& nx) {
    const unsigned G = gridDim.x * gridDim.y * gridDim.z;
    unsigned sum, cnt, mine, sp = 0u;
    for (;;) {
        sum = 0u; cnt = 0u; mine = 0u;
#pragma unroll
        for (unsigned j = 0; j < 16; ++j) { const unsigned c = xb_ld(&bar[XB_XCNT(j)]); sum += c; cnt += (c > 0u) ? 1u : 0u; mine = (j == x) ? c : mine; }
        if (sum == G) break;
        __builtin_amdgcn_s_sleep(1);
        if ((++sp & 255u) == 0u) { if (xb_ld(&bar[XB_TMO])) break; if (sp > XB_SPIN_CAP) { atomicAdd(&bar[XB_TMO], 1u); break; } }
    }
    nloc = mine > 0u ? mine : 1u; nx = cnt > 0u ? cnt : 1u;
}
__device__ __forceinline__ void xcd_barrier(const XcdBarrier& b) {
    asm volatile("s_waitcnt vmcnt(0)" ::: "memory");
    __syncthreads();
    if (threadIdx.x == 0) {
        unsigned* bar = b.bar;
        __builtin_amdgcn_s_waitcnt(0);
        unsigned nloc = b.st[0], nx = b.st[1];
        if (nloc == 0u) { xcd_barrier_complete(bar, b.x, nloc, nx); b.st[0] = nloc; b.st[1] = nx; }
        const unsigned old = xb_add(&bar[XB_XSUB(b.x)], 1u);
        const unsigned gen = old / nloc;
        if (old + 1u == (gen + 1u) * nloc) {
            __builtin_amdgcn_fence(__ATOMIC_RELEASE, "agent");
            asm volatile("s_waitcnt vmcnt(0)" ::: "memory");
            const unsigned og = xb_add(&bar[XB_TOP], 1u);
            const unsigned tg = og / nx;
            if (og + 1u == (tg + 1u) * nx) xb_add(&bar[XB_TOPGEN], 1u);
            else XB_SPIN(xb_ld(&bar[XB_TOPGEN]) == tg, bar);
            __builtin_amdgcn_fence(__ATOMIC_ACQUIRE, "agent");
            xb_add(&bar[XB_XGEN(b.x)], 1u);
            asm volatile("s_waitcnt vmcnt(0)" ::: "memory");
        } else {
            XB_SPIN(xb_ld(&bar[XB_XGEN(b.x)]) == gen, bar);
            __builtin_amdgcn_fence(__ATOMIC_ACQUIRE, "agent");
            asm volatile("s_waitcnt vmcnt(0)" ::: "memory");
        }
    }
    __syncthreads();
}

constexpr int N_PHASES = 20;
typedef const __attribute__((address_space(4))) Args* KArgs;
__device__ __forceinline__ KArgs kargs() { auto p = __builtin_amdgcn_kernarg_segment_ptr(); asm volatile("" : "+s"(p)); return (KArgs)p; }
#ifndef PH_MASK
#define PH_MASK 0xFFFFFu
#endif

__global__ void __launch_bounds__(NTHREADS, 2) hymba_fwd(Args args_unused) {
    extern __shared__ __attribute__((aligned(16))) unsigned char lds_raw[];
    Frame F;
    F.lds = (LAS unsigned char*)lds_raw; F.MISC = (volatile LAS int*)(F.lds + MISC_OFF);
    F.tid = threadIdx.x; F.lane = F.tid & 63; F.wave = __builtin_amdgcn_readfirstlane(F.tid >> 6);
    F.G = gridDim.x; F.gw = blockIdx.x * NWAVES + F.wave; F.NGW = F.G * NWAVES;
    int lo, hi_ph; { KArgs A = kargs(); lo = A->ph_lo; hi_ph = A->ph_hi; }
    for (int u = F.tid; u < 64; u += NTHREADS) F.MISC[u] = 0;
    __syncthreads();
#if MK_N_LAUNCHES == 1
    XcdBarrier bar; { KArgs A = kargs(); bar = xcd_barrier_post((unsigned*)(A->ws + WS_CTL) + CW_BAR, (volatile LAS unsigned*)(F.MISC + 48)); }
#endif
#define IN(k) ((((PH_MASK) >> ((k) > 9 ? (k) - 9 : (k))) & 1u) && lo <= (k) && (k) < hi_ph)
#if MK_N_LAUNCHES == 1
#ifndef USE_CG_ALL
#define USE_CG_ALL 0
#endif
#define SEAM_CG() do { if (kargs()->ws == nullptr) cg::this_grid().sync(); xcd_barrier(bar); } while (0)
#define SEAM() do { if (USE_CG_ALL) cg::this_grid().sync(); else xcd_barrier(bar); } while (0)
#else
#define SEAM() do { } while (0)
#define SEAM_CG() do { } while (0)
#endif
#define WSP(T, off) ((T)(ws + (off)))
#ifndef DUP_MASK
#define DUP_MASK 0u
#endif
#define NREP(k, l0) ((((DUP_MASK) >> (k)) & 1u) && (l0) ? 2 : 1)
#define REP_SEAM() do { if (rep > 0) SEAM(); } while (0)
#define PHASE_TID() do { int t_ = threadIdx.x; asm volatile("" : "+v"(t_)); F.tid = t_; F.lane = t_ & 63; F.wave = __builtin_amdgcn_readfirstlane(t_ >> 6); F.gw = blockIdx.x * NWAVES + F.wave; } while (0)

    if (IN(0)) for (int rep = 0; rep < NREP(0, true); ++rep) {
        KArgs A = kargs(); unsigned char* ws = A->ws; PHASE_TID(); REP_SEAM();
        LAS float* scr = (LAS float*)(F.lds + F.wave * 16384);
        constexpr int per_layer = (1024 / 64) * (NPROJ / 32) + (1024 / 64) * (1024 / 32);
        for (int it0 = F.gw; it0 < 2 * per_layer; it0 += F.NGW) {
            const int l = it0 / per_layer, it = it0 - l * per_layer;
            int base = 0; bool done = false;
            unsigned char* wl = ws + WS_W + (size_t)l * W_LAYER;
            transpose_matrix(F, base, it, A->in[3] + (size_t)l * 1024 * 2468, 1024, 2468, NPROJ, A->in[2] + l * DM, (bf16_t*)(wl + W_IN),
                [](int nb, int& sc, int& nv, int& dr) { const int n0 = 32 * nb; dr = n0; if (n0 < 1280) { sc = n0; nv = 32; } else if (n0 < 2464) { sc = n0 + 4; nv = 32; } else if (n0 == 2464) { sc = 1280; nv = 4; } else { sc = 0; nv = 0; } }, scr, done);
            transpose_matrix(F, base, it, A->in[10] + (size_t)l * 1024 * 1024, 1024, 1024, 1024, nullptr, (bf16_t*)(wl + W_OUT),
                [](int nb, int& sc, int& nv, int& dr) { sc = 32 * nb; nv = 32; dr = 32 * nb; }, scr, done);
        }
        for (int i = blockIdx.x * NTHREADS + F.tid; i < 2 * (98304 + 65536 + 32768 + 4096); i += F.G * NTHREADS) {
            const int l = i / (98304 + 65536 + 32768 + 4096); int r = i - l * (98304 + 65536 + 32768 + 4096); unsigned char* wl = ws + WS_W + (size_t)l * W_LAYER;
            if (r < 98304) { const int nb = r >> 13, ks = (r >> 9) & 15, ln = (r >> 3) & 63, j = r & 7, n = 32 * nb + (ln & 31), k = 16 * ks + 8 * (ln >> 5) + j;
                const float v = A->in[8][(size_t)l * 256 * 384 + (size_t)k * 384 + n] * A->in[6][l * 256 + k]; ((bf16_t*)(wl + W_UQ))[r] = (bf16_t)(cvtpk(v, 0.f) & 0xffffu); continue; }
            r -= 98304;
            if (r < 65536) { const int nb = r >> 12, ks = (r >> 9) & 7, ln = (r >> 3) & 63, j = r & 7, n = 32 * nb + (ln & 31), k = 16 * ks + 8 * (ln >> 5) + j;
                const float v = A->in[9][(size_t)l * 128 * 512 + (size_t)k * 512 + n] * A->in[7][l * 128 + k]; ((bf16_t*)(wl + W_UKV))[r] = (bf16_t)(cvtpk(v, 0.f) & 0xffffu); continue; }
            r -= 65536;
            if (r < 32768) { const int ks = r >> 9, ln = (r >> 3) & 63, j = r & 7, n = ln & 31, k = 16 * ks + 8 * (ln >> 5) + j;
                const float v = A->in[14][(size_t)l * 1024 * 32 + (size_t)k * 32 + n] * A->in[11][l * DM + k]; ((bf16_t*)(wl + W_RT))[r] = (bf16_t)(cvtpk(v, 0.f) & 0xffffu); continue; }
            r -= 32768;
            { const int n = r >> 10, k = r & 1023; const float v = A->in[12][(size_t)l * 1024 * 4 + (size_t)k * 4 + n] * A->in[11][l * DM + k]; ((bf16_t*)(wl + W_RT))[32768 + r] = (bf16_t)(cvtpk(v, 0.f) & 0xffffu); }
        }
        if (blockIdx.x == 0 && F.tid < 256) ((u32x2*)(WSP(bf16_t*, WS_HB) + (size_t)HB_ZERO * DM))[F.tid] = (u32x2){0u, 0u};
        f32x2* ROPE = WSP(f32x2*, WS_SMALL + SM_ROPE);
        for (int i = blockIdx.x * NTHREADS + F.tid; i < 4112 * 16; i += F.G * NTHREADS) { const int pos = i >> 4, f = i & 15;
            const float ang = (float)pos * INV_FREQ[f]; float rev = ang * 0.15915494309189535f; rev -= floorf(rev);
            ROPE[i] = (f32x2){__builtin_amdgcn_cosf(rev), __builtin_amdgcn_sinf(rev)}; }
        __syncthreads();
    }

    for (int layer = 0; layer < 2; ++layer) {
        const int P = 1 + 9 * layer;
        if (IN(P + 0)) for (int rep = 0; rep < NREP(1, layer == 0); ++rep) {
            KArgs A = kargs(); unsigned char* ws = A->ws; PHASE_TID(); REP_SEAM();
            if (layer > 0) expert_tiles_to_lds(F, WSP(const unsigned*, WS_CTL) + CW_CNT + 64 * (layer - 1));
            const NormCtx C{A->in[0], A->in[1], A->out, WSP(float*, WS_SMALL + SM_HMETA), WSP(bf16_t*, WS_HB), A->in[2] + layer * DM, WSP(float*, WS_SMALL + SM_RSA), WSP(const bf16_t*, WS_BIG + BIG_XS),
                            WSP(const int*, WS_SMALL + SM_TOKE), WSP(const int*, WS_SMALL + SM_TOKP), WSP(const float*, WS_SMALL + SM_TOKW), F.MISC};
            if (layer == 0) { for (int m0 = 8 * (F.wave * F.G + (int)blockIdx.x); m0 < MROWS; m0 += 8 * F.NGW) norm_rows<0, 8>(C, m0, MROWS, F.lane); }
            else { for (int m0 = 4 * (F.wave * F.G + (int)blockIdx.x); m0 < MROWS; m0 += 4 * F.NGW) norm_rows<1, 4>(C, m0, MROWS, F.lane);
            }
        }
        if (IN(P + 0) && IN(P + 1)) { if (layer == 0) SEAM_CG(); else SEAM(); }
#ifdef EXTRA_BARRIERS
        for (int xb_ = 0; xb_ < EXTRA_BARRIERS; ++xb_) SEAM();
#endif
        if (IN(P + 1)) for (int rep = 0; rep < NREP(2, layer == 0); ++rep) {
            KArgs A = kargs(); unsigned char* ws = A->ws; PHASE_TID(); REP_SEAM(); unsigned char* wl = ws + WS_W + (size_t)layer * W_LAYER;
            pg8::DenseOrder S; S.init(ws + WS_HB, wl + W_IN, DM, DM, MROWS, NPROJ, F.G, (int)blockIdx.x, true);
            pg8::EpiProj E{WSP(bf16_t*, WS_BIG + BIG_PROJ), NPROJ, WSP(const float*, WS_SMALL + SM_RSA)};
            pg8::gemm_phase<false>(F.tid, F.lds, pg8::Gemm{DM, DM, DM}, S, E);
            for (int t = (int)blockIdx.x; t < 4 * (NPROJ / 32); t += F.G)
                meta_side_task<false>(t, NPROJ / 32, WSP(const bf16_t*, WS_HB) + (size_t)HB_META * DM, (const bf16_t*)(wl + W_IN), WSP(bf16_t*, WS_BIG + BIG_PROJ), NPROJ, WSP(const float*, WS_SMALL + SM_RSA), 0, nullptr, F.lds, F.lane, F.wave);
            for (int t = (7 - F.wave) * F.G + (int)blockIdx.x; t < NB * PADF; t += F.NGW) { const int b = t / PADF, p = t - b * PADF; u32x4* o = (u32x4*)(WSP(bf16_t*, WS_BIG + BIG_PROJ) + ((size_t)b * LSEQ + p) * NPROJ) + F.lane;
#pragma unroll
                for (int q = 0; q < NPROJ / 512; ++q) o[64 * q] = (u32x4){0u, 0u, 0u, 0u}; }
        }
        if (IN(P + 1) && IN(P + 2)) SEAM();
        if (IN(P + 2)) for (int rep = 0; rep < NREP(3, layer == 0); ++rep) {
            KArgs A = kargs(); unsigned char* ws = A->ws; PHASE_TID(); REP_SEAM(); unsigned char* wl = ws + WS_W + (size_t)layer * W_LAYER;
            const bf16_t* PROJ = WSP(const bf16_t*, WS_BIG + BIG_PROJ);
            bf16_t* KM = WSP(bf16_t*, WS_BIG + BIG_KM); bf16_t* VM = WSP(bf16_t*, WS_BIG + BIG_VM);
            unsigned zz = 0u; asm volatile("" : "+v"(zz));
            for (int i = (int)blockIdx.x * NTHREADS + F.tid; i < NB * PADF * 80; i += F.G * NTHREADS) { const int r = i / 80, c = i - 80 * r; const size_t mrow = (size_t)(r / PADF) * LSEQ + r % PADF;
                if (c < 48) *(u32x4*)(KM + mrow * 384 + 8 * c) = (u32x4){zz, zz, zz, zz}; else *(u32x4*)(VM + mrow * 256 + 8 * (c - 48)) = (u32x4){zz, zz, zz, zz}; }
            const bool fsc = (int)blockIdx.x >= F.G - NB;
            if (fsc) fscan_unit(F.G - 1 - (int)blockIdx.x, PROJ, A->in[4] + layer * 4, WSP(float*, WS_SMALL + SM_NEGF), F.lds, F.tid);
            constexpr int UNITS = (NB * 128 + NB / 2) * 20, FQ = 6;
            const int nwo = F.NGW - NB * NWAVES, rest = UNITS - FQ * NB * NWAVES, base = rest / nwo, extra = rest - base * nwo;
            int u0, u1;
            if (!fsc) { const int i = F.gw; u0 = base * i + min(i, extra); u1 = u0 + base + (i < extra ? 1 : 0); }
            else { const int j = F.gw - nwo; u0 = rest + FQ * j; u1 = u0 + FQ; }
#pragma unroll 1
            while (u0 < u1) { const int bi = u0 / 20, l0 = u0 - 20 * bi, l1 = min(20, l0 + (u1 - u0));
                mla_task(bi, min(l0, 12), min(l1, 12), max(l0, 12) - 12, max(l1, 12) - 12, PROJ, (const bf16_t*)(wl + W_UQ), (const bf16_t*)(wl + W_UKV), WSP(const f32x2*, WS_SMALL + SM_ROPE), WSP(bf16_t*, WS_BIG + BIG_QM), KM, VM, F.lane, F.lds + 8192 + F.wave * 4096);
                u0 += l1 - l0; }
        }
        if (IN(P + 2) && IN(P + 3)) SEAM();
        if (IN(P + 3)) for (int rep = 0; rep < NREP(4, layer == 0); ++rep) {
            KArgs A = kargs(); unsigned char* ws = A->ws; PHASE_TID(); REP_SEAM();
            const AttnArgs T{WSP(const bf16_t*, WS_BIG + BIG_PROJ), WSP(const bf16_t*, WS_BIG + BIG_QM), WSP(const bf16_t*, WS_BIG + BIG_KM), WSP(const bf16_t*, WS_BIG + BIG_VM), WSP(const float*, WS_SMALL + SM_NEGF), A->in[5] + layer * 4, WSP(bf16_t*, WS_XN)};
            unsigned* qhead = WSP(unsigned*, WS_CTL) + CW_ATTQ + 64 * layer + 16 * rep;
            constexpr int NU_ATT = 16 * 96, NU_MAIN = NU_ATT + XW_WG_ITEMS, NU_A = 512, NU_META = 128, NU = NU_MAIN + NU_A + NU_META;
            static_assert(NU_ATT == 3 * XW_WG_ITEMS, "one conversion item after every 3 attention units");
            for (;;) {
                if (F.tid == 0) F.MISC[40] = (int)atomicAdd(qhead, 1u);
                __syncthreads();
                const int idx = F.MISC[40];
                __syncthreads();
                if (idx >= NU) break;
                if (idx < NU_MAIN && idx % 4 == 3) {
                    xw_wg_item(idx / 4, F.wave, F.lane, A->in[16] + (size_t)layer * NEXP * 1024 * 512, A->in[17] + (size_t)layer * NEXP * 1024 * 512, A->in[18] + (size_t)layer * NEXP * 512 * 1024, A->in[11] + layer * DM,
                               (bf16_t*)(ws + WS_WMOE + WM_GU), (bf16_t*)(ws + WS_WMOE + WM_DN), (LAS float*)(F.lds + F.wave * 16384)); }
                else if (idx < NU_MAIN) { const int ai_ = idx - (idx + 1) / 4; const int u = 15 - ai_ / 96, rem = ai_ % 96, var = rem >> 5, bh = rem & 31, b = bh >> 2, h = bh & 3;
                    if (var == 2) attn_unit<3>(F.tid, T, b, h, u, F.lds); else if (var == 1) attn_unit<1>(F.tid, T, b, h, u, F.lds); else attn_unit<2>(F.tid, T, b, h, u, F.lds);
#ifdef ATT_DUP_VAR
                    if (ATT_DUP_VAR == 3 && var == 2) attn_unit<3>(F.tid, T, b, h, u, F.lds); if (ATT_DUP_VAR == 1 && var == 1) attn_unit<1>(F.tid, T, b, h, u, F.lds); if (ATT_DUP_VAR == 2 && var == 0) attn_unit<2>(F.tid, T, b, h, u, F.lds);
#endif
                    }
                else if (idx < NU_MAIN + NU_A) { const int r = idx - NU_MAIN, u = 15 - (r >> 5), bh = r & 31; attn_unit<0>(F.tid, T, bh >> 2, bh & 3, u, F.lds); }
                else { const int r = idx - NU_MAIN - NU_A, var = r >> 5, bh = r & 31, b = bh >> 2, h = bh & 3;
                    if (var == 0) attn_unit<0>(F.tid, T, b, h, -1, F.lds); else if (var == 1) attn_unit<1>(F.tid, T, b, h, -1, F.lds); else if (var == 2) attn_unit<2>(F.tid, T, b, h, -1, F.lds); else attn_unit<3>(F.tid, T, b, h, -1, F.lds); }
            }
        }
        if (IN(P + 3) && IN(P + 4)) SEAM();
        if (IN(P + 4)) for (int rep = 0; rep < NREP(5, layer == 0); ++rep) {
            KArgs A = kargs(); unsigned char* ws = A->ws; PHASE_TID(); REP_SEAM(); unsigned char* wl = ws + WS_W + (size_t)layer * W_LAYER;
            float* out = A->out; float* HMETA = WSP(float*, WS_SMALL + SM_HMETA);
            pg8::DenseOrder S; S.init(ws + WS_XN, wl + W_OUT, DM, DM, MROWS, DM, F.G, (int)blockIdx.x, false);
            pg8::EpiResid E{WSP(bf16_t*, WS_HB)};
            pg8::gemm_phase<false>(F.tid, F.lds, pg8::Gemm{DM, DM, DM}, S, E);
            for (int t = (int)blockIdx.x; t < 4 * (DM / 32); t += F.G)
                meta_side_task<true>(t, DM / 32, WSP(const bf16_t*, WS_XN), (const bf16_t*)(wl + W_OUT), WSP(bf16_t*, WS_HB) + (size_t)HB_META * DM, 0, layer == 0 ? A->in[1] : HMETA, layer == 0 ? 0 : 16, HMETA, F.lds, F.lane, F.wave);
        }
        if (IN(P + 4) && IN(P + 5)) SEAM();
        if (IN(P + 5)) for (int rep = 0; rep < NREP(6, layer == 0); ++rep) {
            KArgs A = kargs(); unsigned char* ws = A->ws; PHASE_TID(); REP_SEAM(); unsigned char* wl = ws + WS_W + (size_t)layer * W_LAYER;
            router_phase(F, WSP(const bf16_t*, WS_HB), (const bf16_t*)(wl + W_RT), A->in[13] + layer * 4, A->in[15] + layer * 32,
                         WSP(unsigned*, WS_CTL) + CW_CNT + 64 * layer + 32 * rep, WSP(int*, WS_SMALL + SM_TOKE), WSP(float*, WS_SMALL + SM_TOKW), WSP(int*, WS_SMALL + SM_TOKP), WSP(int*, WS_SMALL + SM_ELIST), WSP(float*, WS_SMALL + SM_RSL));
        }
        if (IN(P + 5) && IN(P + 7)) SEAM();
        if (IN(P + 7)) {
            KArgs A = kargs(); unsigned char* ws = A->ws; PHASE_TID(); unsigned char* wl = ws + WS_W + (size_t)layer * W_LAYER;
            expert_tiles_to_lds(F, WSP(const unsigned*, WS_CTL) + CW_CNT + 64 * layer);
            pg8::GroupedOrder S{(const char*)(ws + WS_HB), (const char*)(ws + WS_WMOE + WM_GU), DM, DM, (size_t)1024 * 1024 * 2, F.MISC, F.MISC[NEXP + 1], F.G, (int)blockIdx.x,
                                WSP(const int*, WS_SMALL + SM_ELIST), WSP(const unsigned*, WS_CTL) + CW_CNT + 64 * layer, true, 0, nullptr};
            pg8::EpiSwiGLU E{WSP(bf16_t*, WS_BIG + BIG_HID), EHID, WSP(const float*, WS_SMALL + SM_RSL)};
            pg8::gemm_phase<true>(F.tid, F.lds, pg8::Gemm{DM, DM, DM}, S, E);
        }
        if (IN(P + 7) && IN(P + 8)) SEAM();
        if (IN(P + 8)) {
            KArgs A = kargs(); unsigned char* ws = A->ws; PHASE_TID(); unsigned char* wl = ws + WS_W + (size_t)layer * W_LAYER;
            expert_tiles_to_lds(F, WSP(const unsigned*, WS_CTL) + CW_CNT + 64 * layer);
            unsigned* latecnt = WSP(unsigned*, WS_CTL) + CW_LATE + 16 * layer;
            { pg8::GroupedOrder S{(const char*)(ws + WS_HB), (const char*)(ws + WS_WMOE + WM_GU), DM, DM, (size_t)1024 * 1024 * 2, F.MISC, F.MISC[NEXP + 1], F.G, (int)blockIdx.x,
                                  WSP(const int*, WS_SMALL + SM_ELIST), WSP(const unsigned*, WS_CTL) + CW_CNT + 64 * layer, true, 1, nullptr};
              pg8::Unit probe;
              if (S.next(0, probe)) {
                  pg8::EpiSwiGLU E{WSP(bf16_t*, WS_BIG + BIG_HID), EHID, WSP(const float*, WS_SMALL + SM_RSL)};
                  pg8::gemm_phase<true>(F.tid, F.lds, pg8::Gemm{DM, DM, DM}, S, E);
                  asm volatile("s_waitcnt vmcnt(0)" ::: "memory"); __syncthreads();
                  if (F.tid == 0) { __builtin_amdgcn_fence(__ATOMIC_RELEASE, "agent"); asm volatile("s_waitcnt vmcnt(0)" ::: "memory"); __hip_atomic_fetch_add(latecnt, 1u, __ATOMIC_RELAXED, __HIP_MEMORY_SCOPE_AGENT); }
                  __syncthreads(); } }
            { KArgs A2 = kargs(); unsigned char* ws2 = A2->ws; PHASE_TID();
              pg8::GroupedOrder S{(const char*)(ws2 + WS_BIG + BIG_HID), (const char*)(ws2 + WS_WMOE + WM_DN), EHID, EHID, (size_t)1024 * 512 * 2, F.MISC, F.MISC[NEXP + 1], F.G, (int)blockIdx.x, nullptr, nullptr, false, 2, latecnt};
              pg8::EpiBf16 E{(bf16_t*)(ws2 + WS_BIG + BIG_XS), DM};
              pg8::gemm_phase<false>(F.tid, F.lds, pg8::Gemm{EHID, EHID, EHID}, S, E); }
        }
        if (IN(P + 8) && IN(P + 9)) SEAM();
    }
    if (IN(19)) {
        KArgs A = kargs(); unsigned char* ws = A->ws; PHASE_TID();
        expert_tiles_to_lds(F, WSP(const unsigned*, WS_CTL) + CW_CNT + 64);
        const NormCtx C{nullptr, nullptr, A->out, nullptr, WSP(bf16_t*, WS_HB), A->in[19], nullptr, WSP(const bf16_t*, WS_BIG + BIG_XS), WSP(const int*, WS_SMALL + SM_TOKE), WSP(const int*, WS_SMALL + SM_TOKP), WSP(const float*, WS_SMALL + SM_TOKW), F.MISC};
        for (int m0 = 4 * (F.wave * F.G + (int)blockIdx.x); m0 < NB * SEQ; m0 += 4 * F.NGW) norm_rows<2, 4>(C, m0, NB * SEQ, F.lane);
    }
#undef IN
#undef SEAM
#undef SEAM_CG
#undef WSP
}

extern "C" void kernel_launch(void* const* d_in, const int* in_sizes, int n_in, void* d_out, int out_size, void* d_ws, size_t ws_size, hipStream_t stream) {
    static int grid = 0;
    if (grid == 0) {
        if (n_in != 20 || out_size != NB * SEQ * DM || ws_size < WS_END) { fprintf(stderr, "kernel_launch: unexpected shapes (n_in %d, out %d, ws %zu < %zu)\n", n_in, out_size, ws_size, (size_t)WS_END); grid = -1; return; }
        int dev = 0, cus = 0, per_cu = 0;
        hipGetDevice(&dev); hipDeviceGetAttribute(&cus, hipDeviceAttributeMultiprocessorCount, dev);
        if (hipFuncSetAttribute((const void*)hymba_fwd, hipFuncAttributeMaxDynamicSharedMemorySize, LDS_BYTES) != hipSuccess) { fprintf(stderr, "kernel_launch: hipFuncSetAttribute failed\n"); grid = -1; return; }
        if (hipOccupancyMaxActiveBlocksPerMultiprocessor(&per_cu, (const void*)hymba_fwd, NTHREADS, LDS_BYTES) != hipSuccess || per_cu < 1) { fprintf(stderr, "kernel_launch: occupancy query failed (%d)\n", per_cu); per_cu = 1; }
        (void)hipGetLastError();
        grid = cus;
    }
    if (grid < 0) return;
    hipMemsetAsync((char*)d_ws + WS_CTL, 0, CTL_BYTES, stream);
    Args a{};
    for (int i = 0; i < 20; ++i) a.in[i] = (const float*)d_in[i];
    a.out = (float*)d_out; a.ws = (unsigned char*)d_ws;
#if MK_N_LAUNCHES == 1
    a.ph_lo = 0; a.ph_hi = N_PHASES;
    void* kargs[] = {&a};
    hipError_t e = hipLaunchCooperativeKernel((const void*)hymba_fwd, dim3(grid), dim3(NTHREADS), kargs, LDS_BYTES, stream);
    if (e != hipSuccess) fprintf(stderr, "cooperative launch failed: %s (grid %d)\n", hipGetErrorString(e), grid);
#else
    for (int ph = 0; ph < N_PHASES; ++ph) { a.ph_lo = ph; a.ph_hi = ph + 1; hipLaunchKernelGGL(hymba_fwd, dim3(grid), dim3(NTHREADS), LDS_BYTES, stream, a); }
#endif
}
```
